# Optimizing an MI355X kernel written in HIP

```python
import math
import jax, jax.numpy as jnp
from jax import lax
import numpy as np

D_MODEL = 1024
BATCH = 4
SEQ = 8192
DEPTH = 1

MIX_WIDTH = D_MODEL
D_RG = MIX_WIDTH // 2
D_S5 = MIX_WIDTH - D_RG
RG_HEADS = 8
RG_HD = D_RG // RG_HEADS
CONV_W = 4
RG_C = 8.0
S5_CH = 16
S5_GROUPS = D_S5 // S5_CH
S5_STATE = 64
MEM_LEN = 256
XA_HEADS = 4
XA_HD = D_MODEL // XA_HEADS
N_EXPERTS = 32
TOP_K = 4
D_FF = D_MODEL
SWIGLU_LIMIT = 7.0
SWIGLU_ALPHA = 1.702
MOE_BLOCK = 128
NORM_EPS = 1e-6

kernel_name = "hymba_rglru_s5_memxattn_moe"


def rmsnorm(x, g):
    xf = x.astype(jnp.float32)
    y = xf * lax.rsqrt(jnp.mean(xf * xf, axis=-1, keepdims=True) + NORM_EPS)
    return (y * g.astype(jnp.float32)).astype(x.dtype)


def causal_depthwise_conv(x, w, b):
    s = x.shape[1]
    xp = jnp.pad(x, ((0, 0), (CONV_W - 1, 0), (0, 0)))
    y = xp[:, 0:s] * w[0]
    for k in range(1, CONV_W):
        y = y + xp[:, k:k + s] * w[k]
    return y + b


def _linear_combine(c1, c2):
    a1, b1 = c1
    a2, b2 = c2
    return a1 * a2, a2 * b1 + b2


def rg_lru_mixer(xa, gate, conv_w, conv_b, rg_wa, rg_ba, rg_wx, rg_bx, rg_lambda):
    bsz, s, _ = xa.shape
    xc = causal_depthwise_conv(xa, conv_w, conv_b)
    xh = xc.reshape(bsz, s, RG_HEADS, RG_HD)
    r = jax.nn.sigmoid(jnp.einsum('bshi,hij->bshj', xh, rg_wa).reshape(bsz, s, D_RG) + rg_ba)
    i = jax.nn.sigmoid(jnp.einsum('bshi,hij->bshj', xh, rg_wx).reshape(bsz, s, D_RG) + rg_bx)
    log_a = -RG_C * r * jax.nn.softplus(-rg_lambda)
    a = jnp.exp(log_a)
    mult = jnp.sqrt(-jnp.expm1(2.0 * log_a))
    is_start = (jnp.arange(s) == 0)[None, :, None]
    mult = jnp.where(is_start, jnp.ones_like(mult), mult)
    b = mult * (i * xc)
    _, h = lax.associative_scan(_linear_combine, (a, b), axis=1)
    return h * jax.nn.gelu(gate)


def _complex_linear_combine(c1, c2):
    ar1, ai1, br1, bi1 = c1
    ar2, ai2, br2, bi2 = c2
    ar = ar2 * ar1 - ai2 * ai1
    ai = ar2 * ai1 + ai2 * ar1
    br = ar2 * br1 - ai2 * bi1 + br2
    bi = ar2 * bi1 + ai2 * br1 + bi2
    return ar, ai, br, bi


def s5_mixer(u, lam_re, lam_im, b_re, b_im, c_re, c_im, d_skip, log_dt, glu_w, glu_b):
    bsz, s, _ = u.shape
    ug = u.reshape(bsz, s, S5_GROUPS, S5_CH)
    dt = jnp.exp(log_dt)[:, None]
    mag = jnp.exp(dt * lam_re)
    abar_re = mag * jnp.cos(dt * lam_im)
    abar_im = mag * jnp.sin(dt * lam_im)
    den = lam_re * lam_re + lam_im * lam_im
    num_re = abar_re - 1.0
    coef_re = (num_re * lam_re + abar_im * lam_im) / den
    coef_im = (abar_im * lam_re - num_re * lam_im) / den
    bbar_re = coef_re[..., None] * b_re - coef_im[..., None] * b_im
    bbar_im = coef_re[..., None] * b_im + coef_im[..., None] * b_re
    bu_re = jnp.einsum('bsgc,gpc->bsgp', ug, bbar_re)
    bu_im = jnp.einsum('bsgc,gpc->bsgp', ug, bbar_im)
    ar = jnp.broadcast_to(abar_re[None, None], (1, s, S5_GROUPS, S5_STATE)).astype(bu_re.dtype)
    ai = jnp.broadcast_to(abar_im[None, None], (1, s, S5_GROUPS, S5_STATE)).astype(bu_re.dtype)
    _, _, h_re, h_im = lax.associative_scan(_complex_linear_combine, (ar, ai, bu_re, bu_im), axis=1)
    y = (jnp.einsum('bsgp,gcp->bsgc', h_re, c_re) - jnp.einsum('bsgp,gcp->bsgc', h_im, c_im)
         + d_skip.reshape(S5_GROUPS, S5_CH) * ug)
    z = jax.nn.gelu(y)
    gate = jax.nn.sigmoid(jnp.einsum('bsgc,gcd->bsgd', z, glu_w) + glu_b.reshape(S5_GROUPS, S5_CH))
    return (z * gate).reshape(bsz, s, D_S5)


def memory_cross_attention(xn, mem, mem_g, xa_wq, xa_wkv, xa_wo):
    bsz, s, _ = xn.shape
    m = mem.shape[1]
    q = (xn @ xa_wq).reshape(bsz, s, XA_HEADS, XA_HD)
    kv = (rmsnorm(mem, mem_g) @ xa_wkv).reshape(bsz, m, 2, XA_HEADS, XA_HD)
    k, v = kv[:, :, 0], kv[:, :, 1]
    scores = jnp.einsum('bshd,bmhd->bhsm', q, k).astype(jnp.float32) * (XA_HD ** -0.5)
    p = jax.nn.softmax(scores, axis=-1).astype(v.dtype)
    o = jnp.einsum('bhsm,bmhd->bshd', p, v).reshape(bsz, s, D_MODEL)
    return o @ xa_wo


def clamped_swiglu_expert(xb, w_gu, b_gu, w_down, b_down):
    gu = xb @ w_gu + b_gu
    g, u = gu[:, :D_FF], gu[:, D_FF:]
    g = jnp.minimum(g, SWIGLU_LIMIT)
    u = jnp.clip(u, -SWIGLU_LIMIT, SWIGLU_LIMIT)
    h = (u + 1.0) * (g * jax.nn.sigmoid(SWIGLU_ALPHA * g))
    return h @ w_down + b_down


def moe_ffn(xn, router_w, router_b, exp_w_gu, exp_b_gu, exp_w_down, exp_b_down):
    bsz, s, d = xn.shape
    n = bsz * s
    xt = xn.reshape(n, d)
    logits = (xt @ router_w + router_b).astype(jnp.float32)
    top_val, top_idx = lax.top_k(logits, TOP_K)
    gates = jax.nn.softmax(top_val, axis=-1).astype(xt.dtype)
    n_assign = n * TOP_K
    e_flat = top_idx.reshape(n_assign)
    t_flat = jnp.repeat(jnp.arange(n, dtype=jnp.int32), TOP_K)
    w_flat = gates.reshape(n_assign)
    order = jnp.argsort(e_flat)
    e_s, t_s, w_s = e_flat[order], t_flat[order], w_flat[order]
    counts = jnp.bincount(e_flat, length=N_EXPERTS)
    padded = ((counts + MOE_BLOCK - 1) // MOE_BLOCK) * MOE_BLOCK
    start = jnp.cumsum(counts) - counts
    pend = jnp.cumsum(padded)
    pstart = pend - padded
    dest = pstart[e_s] + (jnp.arange(n_assign) - start[e_s])
    n_slots = n_assign + N_EXPERTS * MOE_BLOCK
    n_blocks = n_slots // MOE_BLOCK
    slot_tok = jnp.zeros((n_slots,), jnp.int32).at[dest].set(t_s)
    slot_w = jnp.zeros((n_slots,), xt.dtype).at[dest].set(w_s)
    block_exp = jnp.minimum(
        jnp.searchsorted(pend, jnp.arange(n_blocks) * MOE_BLOCK, side='right'), N_EXPERTS - 1)

    def run_block(args):
        tok, e = args
        return clamped_swiglu_expert(xt[tok], exp_w_gu[e], exp_b_gu[e], exp_w_down[e], exp_b_down[e])

    yb = lax.map(run_block, (slot_tok.reshape(n_blocks, MOE_BLOCK), block_exp))
    y = jnp.zeros((n, d), xt.dtype).at[slot_tok].add(yb.reshape(n_slots, d) * slot_w[:, None])
    return y.reshape(bsz, s, d)


def setup_inputs(seed: int = 0) -> dict:
    key = jax.random.key(seed)
    ks = jax.random.split(key, 40)
    f32 = jnp.float32
    nrm = lambda k, shape, scale: jax.random.normal(k, shape, f32) * scale
    gain = lambda k, n: 1.0 + 0.01 * jax.random.normal(k, (n,), f32)
    a0 = jax.random.uniform(ks[10], (D_RG,), f32, 0.9, 0.999)
    sa = a0 ** (1.0 / RG_C)
    rg_lambda = jnp.log(sa) - jnp.log1p(-sa)
    n_idx = jnp.arange(S5_STATE, dtype=f32)
    lam_re = -0.5 + 0.01 * jax.random.normal(ks[11], (S5_GROUPS, S5_STATE), f32)
    lam_im = jnp.pi * n_idx[None, :] + 0.01 * jax.random.normal(ks[12], (S5_GROUPS, S5_STATE), f32)
    log_dt = jax.random.uniform(ks[13], (S5_GROUPS,), f32, math.log(0.001), math.log(0.1))
    return {
        "x": jax.random.normal(ks[0], (BATCH, SEQ, D_MODEL), f32),
        "mem": jax.random.normal(ks[1], (BATCH, MEM_LEN, D_MODEL), f32),
        "norm_mix_g": gain(ks[2], D_MODEL),
        "w_in": nrm(ks[3], (D_MODEL, 2 * D_RG + D_S5), D_MODEL ** -0.5),
        "conv_w": nrm(ks[4], (CONV_W, D_RG), CONV_W ** -0.5),
        "conv_b": nrm(ks[5], (D_RG,), 0.01),
        "rg_wa": nrm(ks[6], (RG_HEADS, RG_HD, RG_HD), RG_HD ** -0.5),
        "rg_ba": nrm(ks[7], (D_RG,), 0.01),
        "rg_wx": nrm(ks[8], (RG_HEADS, RG_HD, RG_HD), RG_HD ** -0.5),
        "rg_bx": nrm(ks[9], (D_RG,), 0.01),
        "rg_lambda": rg_lambda,
        "s5_lambda_re": lam_re,
        "s5_lambda_im": lam_im,
        "s5_b_re": nrm(ks[14], (S5_GROUPS, S5_STATE, S5_CH), (2.0 * S5_CH) ** -0.5),
        "s5_b_im": nrm(ks[15], (S5_GROUPS, S5_STATE, S5_CH), (2.0 * S5_CH) ** -0.5),
        "s5_c_re": nrm(ks[16], (S5_GROUPS, S5_CH, S5_STATE), (S5_STATE) ** -0.5),
        "s5_c_im": nrm(ks[17], (S5_GROUPS, S5_CH, S5_STATE), (S5_STATE) ** -0.5),
        "s5_d": nrm(ks[18], (D_S5,), 1.0),
        "s5_log_dt": log_dt,
        "s5_glu_w": nrm(ks[19], (S5_GROUPS, S5_CH, S5_CH), S5_CH ** -0.5),
        "s5_glu_b": nrm(ks[20], (D_S5,), 0.01),
        "w_out": nrm(ks[21], (MIX_WIDTH, D_MODEL), MIX_WIDTH ** -0.5),
        "norm_xa_g": gain(ks[22], D_MODEL),
        "mem_norm_g": gain(ks[23], D_MODEL),
        "xa_wq": nrm(ks[24], (D_MODEL, D_MODEL), D_MODEL ** -0.5),
        "xa_wkv": nrm(ks[25], (D_MODEL, 2 * D_MODEL), D_MODEL ** -0.5),
        "xa_wo": nrm(ks[26], (D_MODEL, D_MODEL), D_MODEL ** -0.5),
        "norm_ffn_g": gain(ks[27], D_MODEL),
        "router_w": nrm(ks[28], (D_MODEL, N_EXPERTS), D_MODEL ** -0.5),
        "router_b": nrm(ks[29], (N_EXPERTS,), 0.01),
        "exp_w_gu": nrm(ks[30], (N_EXPERTS, D_MODEL, 2 * D_FF), D_MODEL ** -0.5),
        "exp_b_gu": nrm(ks[31], (N_EXPERTS, 2 * D_FF), 0.01),
        "exp_w_down": nrm(ks[32], (N_EXPERTS, D_FF, D_MODEL), D_FF ** -0.5),
        "exp_b_down": nrm(ks[33], (N_EXPERTS, D_MODEL), 0.01),
        "final_norm_g": gain(ks[34], D_MODEL),
    }


def reference(x, mem, norm_mix_g, w_in, conv_w, conv_b, rg_wa, rg_ba, rg_wx, rg_bx, rg_lambda,
              s5_lambda_re, s5_lambda_im, s5_b_re, s5_b_im, s5_c_re, s5_c_im, s5_d, s5_log_dt,
              s5_glu_w, s5_glu_b, w_out, norm_xa_g, mem_norm_g, xa_wq, xa_wkv, xa_wo,
              norm_ffn_g, router_w, router_b, exp_w_gu, exp_b_gu, exp_w_down, exp_b_down,
              final_norm_g):
    h = x
    for _ in range(DEPTH):
        xn = rmsnorm(h, norm_mix_g)
        proj = xn @ w_in
        gate_rg = proj[..., :D_RG]
        x_rg = proj[..., D_RG:2 * D_RG]
        u_s5 = proj[..., 2 * D_RG:]
        y_rg = rg_lru_mixer(x_rg, gate_rg, conv_w, conv_b, rg_wa, rg_ba, rg_wx, rg_bx, rg_lambda)
        y_s5 = s5_mixer(u_s5, s5_lambda_re, s5_lambda_im, s5_b_re, s5_b_im, s5_c_re, s5_c_im,
                        s5_d, s5_log_dt, s5_glu_w, s5_glu_b)
        h = h + jnp.concatenate([y_rg, y_s5], axis=-1) @ w_out
        h = h + memory_cross_attention(rmsnorm(h, norm_xa_g), mem, mem_norm_g, xa_wq, xa_wkv, xa_wo)
        h = h + moe_ffn(rmsnorm(h, norm_ffn_g), router_w, router_b, exp_w_gu, exp_b_gu,
                        exp_w_down, exp_b_down)
    return rmsnorm(h, final_norm_g)
```

```cpp
#include <hip/hip_runtime.h>
#include <cstdio>
#include <cstdint>

#ifndef MK_N_LAUNCHES
#define MK_N_LAUNCHES 1
#endif
#ifndef MK_MAX_PHASE
#define MK_MAX_PHASE 14
#endif

#define LAS __attribute__((address_space(3)))
#define GAS __attribute__((address_space(1)))
typedef unsigned short bf16_t;
typedef short bf16x8 __attribute__((ext_vector_type(8)));
typedef float f32x4 __attribute__((ext_vector_type(4)));
typedef float f32x2 __attribute__((ext_vector_type(2)));
typedef unsigned u32x4 __attribute__((ext_vector_type(4)));
typedef unsigned u32x2 __attribute__((ext_vector_type(2)));
typedef int i32x4 __attribute__((ext_vector_type(4)));
typedef int i32x8 __attribute__((ext_vector_type(8)));

constexpr int BATCH = 4, SEQ = 8192, D = 1024, M = BATCH * SEQ;
constexpr int NPROJ = 1536;
constexpr int MEMLEN = 256, NH = 4, HD = 256;
constexpr int NE = 32, ECAP = 32768;
constexpr float NORM_EPS = 1e-6f;
constexpr int RG_TCH = 128, RG_NCH = SEQ / RG_TCH;
constexpr int S5_TCH = 512, S5_NCH = SEQ / S5_TCH;
constexpr int SLOT_ROWS = M * 4 + NE * 256;
constexpr float QSCALE = 0.0625f * 1.44269504088896f;

constexpr size_t MiB = 1u << 20;
constexpr size_t WS_CTL = 0, CTL_ZERO_BYTES = 1 * MiB;
constexpr int CW_BAR = 4096;
constexpr int CW_CNT = 8192;
constexpr size_t WS_SS1 = 256 * 1024, WS_SS2 = 384 * 1024;
constexpr size_t WS_SMALL = 1 * MiB;
constexpr size_t WS_RGWT = WS_SMALL + 0;
constexpr size_t WS_S5BT = WS_SMALL + 128 * 1024;
constexpr size_t WS_S5CT = WS_SMALL + 384 * 1024;
constexpr size_t WS_S5GT = WS_SMALL + 512 * 1024;
constexpr size_t WS_WRT  = WS_SMALL + 576 * 1024;
constexpr size_t WS_SP8  = WS_SMALL + 640 * 1024;
constexpr size_t WS_S5A  = WS_SMALL + 648 * 1024;
constexpr size_t WS_S5AL = WS_SMALL + 664 * 1024;
constexpr size_t WS_RGP = 2 * MiB, WS_RGH = WS_RGP + 512 * 1024, WS_RGHIN = 3 * MiB;
constexpr size_t WS_S5H = 4 * MiB, WS_S5HIN = 5 * MiB;
constexpr size_t WS_KB = 6 * MiB, WS_VT = 8 * MiB;
constexpr size_t WS_MEMB = 10 * MiB;
constexpr size_t WS_WIN = 12 * MiB, WS_WOUT = 15 * MiB, WS_WQ = 17 * MiB, WS_WO = 19 * MiB, WS_WKV = 21 * MiB;
constexpr size_t WS_LTOK = 26 * MiB, WS_LRS = 30 * MiB, WS_EP = 34 * MiB, WS_WK = WS_EP + 512 * 1024;
constexpr size_t WS_WGU = 36 * MiB, WS_WDN = 164 * MiB;
constexpr size_t WS_HB = 228 * MiB;
constexpr size_t WS_HB8 = 100 * MiB;
constexpr float W8_SCALE = 64.f, W8_INV = 1.0f / 64.f;
constexpr size_t WS_XB = 292 * MiB, WS_PROJ = 356 * MiB, WS_YCAT = 452 * MiB, WS_QB = 516 * MiB, WS_OB = 580 * MiB;
constexpr size_t WS_HMOE = 292 * MiB;
constexpr size_t WS_XG8 = 428 * MiB;
constexpr size_t WS_YSLOT = 644 * MiB;
constexpr size_t WS_END = 916 * MiB;

constexpr int RING_BYTES = 150016;
constexpr int MISC_OFF = RING_BYTES + 64;
constexpr int BIAS_OFF = 131072 + 512;
constexpr int GTAB_OFF = 131072 + 512 + 2048;
constexpr int LDS_BYTES = 158208;

typedef __bf16 bf16x2v __attribute__((ext_vector_type(2)));
__device__ __forceinline__ unsigned pk2(float lo, float hi) { const f32x2 v = {lo, hi}; const bf16x2v b = __builtin_convertvector(v, bf16x2v); return __builtin_bit_cast(unsigned, b); }
__device__ __forceinline__ unsigned cvt_pk_bf16(float lo, float hi) { return pk2(lo, hi); }
__device__ __forceinline__ unsigned pk4_fp8(float a, float b, float c, float d) { int w = __builtin_amdgcn_cvt_pk_fp8_f32(a, b, 0, false); w = __builtin_amdgcn_cvt_pk_fp8_f32(c, d, w, true); return (unsigned)w; }
__device__ __forceinline__ bf16_t f2bf(float x) { return (bf16_t)(pk2(x, 0.f) & 0xffffu); }
__device__ __forceinline__ float bf2f(bf16_t x) { return __uint_as_float((unsigned)x << 16); }
__device__ __forceinline__ float bflo(unsigned w) { return __uint_as_float(w << 16); }
__device__ __forceinline__ float bfhi(unsigned w) { return __uint_as_float(w & 0xffff0000u); }
__device__ __forceinline__ float sigmoidf_(float x) { return __builtin_amdgcn_rcpf(1.f + __expf(-x)); }
__device__ __forceinline__ float gelu_tanh(float x) { return x * sigmoidf_(1.5957691216057308f * (x + 0.044715f * x * x * x)); }
__device__ __forceinline__ float wave_sum(float v) {
#pragma unroll
    for (int o = 1; o < 64; o <<= 1) v += __shfl_xor(v, o);
    return v;
}
__device__ __forceinline__ int lane_id() { return (int)__builtin_amdgcn_mbcnt_hi(~0u, __builtin_amdgcn_mbcnt_lo(~0u, 0u)); }
#define LDS_WAIT() asm volatile("s_waitcnt lgkmcnt(0)" ::: "memory")
#define VM_WAIT() asm volatile("s_waitcnt vmcnt(0)" ::: "memory")

namespace pg8 {
#define PG8_LAS __attribute__((address_space(3)))
constexpr int BM = 256, BK = 64, HALF = 128, HTB = HALF * BK * 2, STAGE_BYTES = 8 * HTB, NXCD = 8, WGM = 8;
__host__ __device__ __forceinline__ int lds_byte(int r, int c) { const int st = (r >> 4) * 2 + (c >> 5), rr = r & 15, cc = c & 31, ob = rr * 64 + cc * 2; return st * 1024 + (ob ^ (((ob >> 9) & 1) << 5)); }
__host__ __device__ __forceinline__ void stage_rc(int b, int& R, int& C) { const int st = b / 1024, sb = b % 1024, swz = sb ^ (((sb >> 9) & 1) << 5); R = (st >> 1) * 16 + swz / 64; C = (st & 1) * 32 + (swz % 64) / 2; }
__host__ __device__ __forceinline__ int perm32(int rho) { const int n = rho >> 4, i = rho & 15; return 8 * (i >> 2) + 4 * n + (i & 3); }

struct Unit { int pm, pn, pb, e, r0, ne; };
struct Gemm { const void* A; const void* Bt; int KB; };

struct StaticOrder {
    int nM, nN, nwg, G, c;
    __device__ void init(int M_, int N_, int G_, int c_) { nM = M_ / BM; nN = N_ / BM; nwg = nM * nN; G = G_; c = c_; }
    __device__ bool next(int i, Unit& u) const {
        const long L = (long)i * G + c; if (L >= nwg) return false;
        int wgid = (int)L; { const int q = nwg / NXCD, r = nwg % NXCD, xcd = wgid % NXCD, off = wgid / NXCD; wgid = (xcd < r ? xcd * (q + 1) : r * (q + 1) + (xcd - r) * q) + off; }
        const int nig = WGM * nN, gid = wgid / nig, fm = gid * WGM, gsz = (nM - fm) < WGM ? (nM - fm) : WGM;
        u.pm = fm + ((wgid % nig) % gsz); u.pn = (wgid % nig) / gsz; u.pb = u.pn; u.e = 0; u.r0 = 0; u.ne = 0; return true;
    }
    __device__ __forceinline__ int row_tok(const Unit&, int) const { return 0; }
};

template <class Epi, class Sched, bool GATHER, bool ALIGN_EPI, bool FP8 = false>
__device__ __forceinline__ void gemm_phase(PG8_LAS unsigned char* lds, const Gemm g, const Sched& S, Epi E, const int wid) {
    int tid = wid * 64 + lane_id(); asm volatile("" : "+v"(tid));
    const int lane = tid & 63, wr = wid >> 2, wc = wid & 3, fr = lane & 15, fq = lane >> 4;
    const int KB = g.KB, nt = KB / (BK * 2);
    unsigned voffA[2], voffB[2];
#pragma unroll
    for (int i = 0; i < 2; ++i) { int R, C; stage_rc(tid * 16 + i * 8192, R, C); const int Rb = Epi::PERM ? ((R & ~31) + perm32(R & 31)) : R;
        voffA[i] = (unsigned)(R * KB + C * 2); voffB[i] = (unsigned)(Rb * KB + C * 2); }
    const unsigned kstep = (unsigned)(BK * 2);
    const unsigned hstep = (unsigned)HALF * (unsigned)KB;
    const unsigned tstep = 2u * hstep;
    const __amdgpu_buffer_rsrc_t rA = __builtin_amdgcn_make_buffer_rsrc((void*)g.A, (short)0, 0x7fffffff, 0x00020000);
    const __amdgpu_buffer_rsrc_t rB = __builtin_amdgcn_make_buffer_rsrc((void*)g.Bt, (short)0, 0x7fffffff, 0x00020000);
    const unsigned ldsw = (unsigned)wid * 1024u;
    const int aoff = lds_byte(wr * 64 + fr, fq * 8), boff = lds_byte(wc * 32 + fr, fq * 8);
    PG8_LAS unsigned* gslot = (PG8_LAS unsigned*)(lds + GTAB_OFF) + tid * 4;
    PG8_LAS unsigned* nslot = gslot + 2048;
    unsigned ntk[4] = {0u, 0u, 0u, 0u};
#define PG8_SA(b, h) (((b) * 2 + (h)) * HTB)
#define PG8_SB(b, h) ((4 + (b) * 2 + (h)) * HTB)
#define PG8_STAGE_B(bufoff, soff) do { _Pragma("unroll") for (int _i = 0; _i < 2; ++_i) \
        __builtin_amdgcn_raw_ptr_buffer_load_lds(rB, (PG8_LAS unsigned*)(lds + (bufoff) + ldsw + _i * 8192), 16, voffB[_i], (soff), 0, 0); } while (0)
#define PG8_STAGE_A(bufoff, nx, kb, h) do { _Pragma("unroll") for (int _i = 0; _i < 2; ++_i) { \
        if constexpr (GATHER) __builtin_amdgcn_raw_ptr_buffer_load_lds(rA, (PG8_LAS unsigned*)(lds + (bufoff) + ldsw + _i * 8192), 16, gslot[(h) * 2 + _i], (kb), 0, 0); \
        else __builtin_amdgcn_raw_ptr_buffer_load_lds(rA, (PG8_LAS unsigned*)(lds + (bufoff) + ldsw + _i * 8192), 16, voffA[_i], ((nx) ? nA : cA) + (kb) + (unsigned)(h) * hstep, 0, 0); } } while (0)
#define PG8_LDA(dst, b, h) do { _Pragma("unroll") for (int m = 0; m < 4; ++m) _Pragma("unroll") for (int k = 0; k < 2; ++k) dst[m][k] = *(const PG8_LAS bf16x8*)(lds + PG8_SA(b, h) + aoff + m * 2048 + k * 1024); } while (0)
#define PG8_LDB(dst, b, h) do { _Pragma("unroll") for (int n = 0; n < 2; ++n) _Pragma("unroll") for (int k = 0; k < 2; ++k) dst[n][k] = *(const PG8_LAS bf16x8*)(lds + PG8_SB(b, h) + boff + n * 2048 + k * 1024); } while (0)
#define PG8_CAT(x) __builtin_shufflevector(__builtin_bit_cast(i32x4, x[0]), __builtin_bit_cast(i32x4, x[1]), 0, 1, 2, 3, 4, 5, 6, 7)
#define PG8_MMA(ai, bj, At, Bt) do { __builtin_amdgcn_s_setprio(1); \
        if constexpr (FP8) { _Pragma("unroll") for (int m = 0; m < 4; ++m) _Pragma("unroll") for (int n = 0; n < 2; ++n) \
            acc[ai][bj][m][n] = __builtin_amdgcn_mfma_scale_f32_16x16x128_f8f6f4(PG8_CAT(Bt[n]), PG8_CAT(At[m]), acc[ai][bj][m][n], 0, 0, 0, 0, 0, 0); } \
        else { _Pragma("unroll") for (int m = 0; m < 4; ++m) _Pragma("unroll") for (int n = 0; n < 2; ++n) _Pragma("unroll") for (int k = 0; k < 2; ++k) \
            acc[ai][bj][m][n] = __builtin_amdgcn_mfma_f32_16x16x32_bf16(Bt[n][k], At[m][k], acc[ai][bj][m][n], 0, 0, 0); } \
        __builtin_amdgcn_s_setprio(0); } while (0)
#define PG8_WAIT_V(n) asm volatile("s_waitcnt vmcnt(" #n ")" ::: "memory")
#define PG8_WAIT_L(n) asm volatile("s_waitcnt lgkmcnt(" #n ")" ::: "memory")
#define PG8_BAR __builtin_amdgcn_s_barrier()
#define PG8_SCHED __builtin_amdgcn_sched_barrier(0)
#define PG8_GROW(h_, u) do { if constexpr (GATHER) { _Pragma("unroll") for (int _i = 0; _i < 2; ++_i) { int _R, _C; stage_rc(tid * 16 + _i * 8192, _R, _C); \
        gslot[(h_) * 2 + _i] = (unsigned)S.row_tok(u, _R + (h_) * HALF) * (unsigned)KB + (unsigned)(_C * 2); } } } while (0)
    Unit cur, nxt; int ui = 0;
    if (!S.next(0, cur)) return;
    f32x4 acc[2][2][4][2];
#pragma unroll
    for (int a = 0; a < 2; ++a)
#pragma unroll
        for (int b = 0; b < 2; ++b)
#pragma unroll
            for (int m = 0; m < 4; ++m)
#pragma unroll
                for (int n = 0; n < 2; ++n) acc[a][b][m][n] = (f32x4){0.f, 0.f, 0.f, 0.f};
    bf16x8 At[4][2], B0[2][2], B1[2][2];
    unsigned cA = (unsigned)cur.pm * tstep, cB = (unsigned)cur.pb * tstep;
    unsigned nA = cA;
    PG8_GROW(0, cur); PG8_GROW(1, cur);
    PG8_STAGE_B(PG8_SB(0, 0), cB); PG8_STAGE_B(PG8_SB(0, 1), cB + hstep); PG8_STAGE_A(PG8_SA(0, 0), false, 0, 0); PG8_STAGE_A(PG8_SA(0, 1), false, 0, 1);
    if (wr == 1) PG8_BAR;
    PG8_WAIT_V(2); PG8_BAR;
    PG8_STAGE_B(PG8_SB(1, 0), cB + kstep); PG8_STAGE_A(PG8_SA(1, 0), false, kstep, 0); PG8_STAGE_B(PG8_SB(1, 1), cB + hstep + kstep);
    PG8_WAIT_V(6); PG8_BAR;
    for (;;) {
        const bool has_next = S.next(ui + 1, nxt);
        if constexpr (Epi::LDSBIAS) { if (wid == 0) E.prefetch(cur, (PG8_LAS unsigned*)(lds + BIAS_OFF + (ui & 1) * 1024), lane); }
        if constexpr (GATHER) { if (has_next) {
#pragma unroll
            for (int _h = 0; _h < 2; ++_h)
#pragma unroll
                for (int _i = 0; _i < 2; ++_i) { int _R, _C; stage_rc(tid * 16 + _i * 8192, _R, _C); ntk[_h * 2 + _i] = (unsigned)S.row_tok(nxt, _R + _h * HALF) * (unsigned)KB + (unsigned)(_C * 2); } } }
        nA = has_next ? (unsigned)nxt.pm * tstep : cA; const unsigned nB = has_next ? (unsigned)nxt.pb * tstep : cB;
#pragma nounroll
        for (int t = 0; t < nt; t += 2) {
            const bool last = (t == nt - 2);
            const unsigned kb1 = (unsigned)(t + 1) * kstep;
            const unsigned kb2 = last ? 0u : (unsigned)(t + 2) * kstep; const unsigned b2 = last ? nB : cB + (unsigned)(t + 2) * kstep;
            const unsigned kb3 = kb2 + kstep; const unsigned b3 = b2 + kstep;
            if constexpr (GATHER) { if (has_next && (t == 2 || nt == 2)) { nslot[0] = ntk[0]; nslot[1] = ntk[1]; nslot[2] = ntk[2]; nslot[3] = ntk[3]; }
                if (last && has_next) { gslot[0] = nslot[0]; gslot[1] = nslot[1]; } }
            PG8_LDB(B0, 0, 0); PG8_LDB(B1, 0, 1); PG8_SCHED; PG8_LDA(At, 0, 0); PG8_STAGE_A(PG8_SA(1, 1), false, kb1, 1);
            if constexpr (GATHER) { if (last && has_next) { gslot[2] = nslot[2]; gslot[3] = nslot[3]; } }
            PG8_WAIT_V(8); PG8_WAIT_L(0); PG8_BAR; PG8_MMA(0, 0, At, B0); PG8_MMA(0, 1, At, B1); PG8_BAR; PG8_SCHED;
            PG8_LDA(At, 0, 1); PG8_STAGE_B(PG8_SB(0, 0), b2); PG8_STAGE_B(PG8_SB(0, 1), b2 + hstep); PG8_STAGE_A(PG8_SA(0, 0), last, kb2, 0);
            PG8_WAIT_V(8); PG8_WAIT_L(0); PG8_BAR; PG8_MMA(1, 0, At, B0); PG8_MMA(1, 1, At, B1); PG8_BAR; PG8_SCHED;
            PG8_LDB(B0, 1, 0); PG8_LDB(B1, 1, 1); PG8_SCHED; PG8_LDA(At, 1, 0); PG8_STAGE_A(PG8_SA(0, 1), last, kb2, 1);
            PG8_WAIT_V(8); PG8_WAIT_L(0); PG8_BAR; PG8_MMA(0, 0, At, B0); PG8_MMA(0, 1, At, B1); PG8_BAR; PG8_SCHED;
            PG8_LDA(At, 1, 1); PG8_STAGE_B(PG8_SB(1, 0), b3); PG8_STAGE_B(PG8_SB(1, 1), b3 + hstep); PG8_STAGE_A(PG8_SA(1, 0), last, kb3, 0);
            PG8_WAIT_V(8); PG8_WAIT_L(0); PG8_BAR; PG8_MMA(1, 0, At, B0); PG8_MMA(1, 1, At, B1); PG8_BAR; PG8_SCHED;
        }
        if constexpr (ALIGN_EPI) { if (wr == 0) PG8_BAR; }
        { int et = lane_id(); asm volatile("" : "+v"(et)); if constexpr (Epi::LDSBIAS) E.slot = (const PG8_LAS float*)(lds + BIAS_OFF + (ui & 1) * 1024); E(acc, cur, wr, wc, et & 15, et >> 4); }
        if (!has_next) break;
#pragma unroll
        for (int a = 0; a < 2; ++a)
#pragma unroll
            for (int b = 0; b < 2; ++b)
#pragma unroll
                for (int m = 0; m < 4; ++m)
#pragma unroll
                    for (int n = 0; n < 2; ++n) acc[a][b][m][n] = (f32x4){0.f, 0.f, 0.f, 0.f};
        cur = nxt; cA = nA; cB = nB; ++ui;
        if constexpr (ALIGN_EPI) { if (wr == 1) PG8_BAR; }
    }
    PG8_WAIT_V(0);
    if constexpr (!ALIGN_EPI) { if (wr == 0) PG8_BAR; }
    PG8_BAR;
#undef PG8_SA
#undef PG8_SB
#undef PG8_STAGE_A
#undef PG8_STAGE_B
#undef PG8_LDA
#undef PG8_LDB
#undef PG8_MMA
#undef PG8_CAT
#undef PG8_WAIT_V
#undef PG8_WAIT_L
#undef PG8_BAR
#undef PG8_SCHED
#undef PG8_GROW
}

template <int MODE> struct EpiBf16 {
    static constexpr bool PERM = true, LDSBIAS = (MODE == 2); const PG8_LAS float* slot;
    bf16_t* O; int ldc; const float* aux; float cst;
    __device__ __forceinline__ void prefetch(const Unit& u, PG8_LAS unsigned* dst, int lane) const {
        const __amdgpu_buffer_rsrc_t r = __builtin_amdgcn_make_buffer_rsrc((void*)aux, (short)0, NE * 1024 * 4, 0x00020000);
        __builtin_amdgcn_raw_ptr_buffer_load_lds(r, dst, 16, (unsigned)lane * 16u, (unsigned)(u.e * 1024 + u.pn * BM) * 4u, 0, 0); }
    __device__ __forceinline__ void operator()(const f32x4 (&acc)[2][2][4][2], const Unit& u, int wr, int wc, int fr, int fq) const {
        const int row0 = u.pm * BM + wr * 64 + fr, col0 = u.pn * BM + wc * 32 + 8 * fq;
        f32x4 bv[2][2];
#pragma unroll
        for (int bj = 0; bj < 2; ++bj)
#pragma unroll
            for (int n = 0; n < 2; ++n) bv[bj][n] = (MODE == 2) ? *(const PG8_LAS f32x4*)(slot + wc * 32 + 8 * fq + bj * HALF + 4 * n) : (f32x4){0.f, 0.f, 0.f, 0.f};
        if constexpr (MODE == 2) {
            const bool odd = (fq & 1) != 0;
#pragma unroll
            for (int ai = 0; ai < 2; ++ai)
#pragma unroll
                for (int m0 = 0; m0 < 4; m0 += 2)
#pragma unroll
                    for (int bj = 0; bj < 2; ++bj) { u32x2 w8[2];
#pragma unroll
                        for (int mm = 0; mm < 2; ++mm) { const f32x4 v0 = acc[ai][bj][m0 + mm][0] * cst + bv[bj][0], v1 = acc[ai][bj][m0 + mm][1] * cst + bv[bj][1];
                            w8[mm].x = pk4_fp8(v0[0], v0[1], v0[2], v0[3]); w8[mm].y = pk4_fp8(v1[0], v1[1], v1[2], v1[3]); }
                        const unsigned sx = odd ? w8[0].x : w8[1].x, sy = odd ? w8[0].y : w8[1].y;
                        const unsigned rx = (unsigned)__builtin_amdgcn_ds_swizzle((int)sx, 0x401F), ry = (unsigned)__builtin_amdgcn_ds_swizzle((int)sy, 0x401F);
                        u32x4 o; o.x = odd ? rx : w8[0].x; o.y = odd ? ry : w8[0].y; o.z = odd ? w8[1].x : rx; o.w = odd ? w8[1].y : ry;
                        const int row = row0 + ai * HALF + (m0 + (odd ? 1 : 0)) * 16;
                        *(u32x4*)((unsigned char*)O + (size_t)row * ldc + col0 + bj * HALF - (odd ? 8 : 0)) = o; }
            return; }
#pragma unroll
        for (int ai = 0; ai < 2; ++ai)
#pragma unroll
            for (int m = 0; m < 4; ++m) { const int row = row0 + ai * HALF + m * 16; bf16_t* rowp = O + (size_t)row * ldc + col0;
                float sc = 1.f; if (MODE == 1) sc = rsqrtf(aux[row] * (1.0f / D) + NORM_EPS) * cst;
#pragma unroll
                for (int bj = 0; bj < 2; ++bj) { const f32x4 v0 = acc[ai][bj][m][0] * sc + bv[bj][0], v1 = acc[ai][bj][m][1] * sc + bv[bj][1];
                    u32x4 w; w.x = cvt_pk_bf16(v0[0], v0[1]); w.y = cvt_pk_bf16(v0[2], v0[3]); w.z = cvt_pk_bf16(v1[0], v1[1]); w.w = cvt_pk_bf16(v1[2], v1[3]);
                    *(u32x4*)(rowp + bj * HALF) = w; } }
    }
};
struct EpiKV {
    static constexpr bool PERM = false, LDSBIAS = false;
    bf16_t* KB; bf16_t* VT;
    __device__ __forceinline__ void operator()(const f32x4 (&acc)[2][2][4][2], const Unit& u, int wr, int wc, int fr, int fq) const {
        const int b = u.pm, isv = u.pn >> 2, h = u.pn & 3;
#pragma unroll
        for (int ai = 0; ai < 2; ++ai)
#pragma unroll
            for (int m = 0; m < 4; ++m) { const int mem = ai * HALF + wr * 64 + m * 16 + fr;
                const int pmem = (mem & ~31) + 8 * ((mem >> 2) & 3) + 4 * ((mem >> 4) & 1) + (mem & 3);
#pragma unroll
                for (int bj = 0; bj < 2; ++bj)
#pragma unroll
                    for (int n = 0; n < 2; ++n) { const int d0 = bj * HALF + wc * 32 + n * 16 + 4 * fq; const f32x4 v = acc[ai][bj][m][n];
                        if (!isv) { u32x2 w; w.x = cvt_pk_bf16(v[0], v[1]); w.y = cvt_pk_bf16(v[2], v[3]); *(u32x2*)(KB + ((size_t)((b * NH + h) * MEMLEN + mem)) * HD + d0) = w; }
                        else {
#pragma unroll
                            for (int j = 0; j < 4; ++j) VT[((size_t)((b * NH + h) * HD + d0 + j)) * MEMLEN + pmem] = f2bf(v[j]); } } }
    }
};
template <bool BF16BASE> struct EpiRes {
    static constexpr bool PERM = true, LDSBIAS = false;
    const float* base; bf16_t* hb; float* ss;
    __device__ __forceinline__ void operator()(const f32x4 (&acc)[2][2][4][2], const Unit& u, int wr, int wc, int fr, int fq) const {
        const int row0 = u.pm * BM + wr * 64 + fr, col0 = u.pn * BM + wc * 32 + 8 * fq;
#pragma unroll
        for (int ai = 0; ai < 2; ++ai)
#pragma unroll
            for (int m = 0; m < 4; ++m) { const int row = row0 + ai * HALF + m * 16; const size_t off = (size_t)row * D + col0; float s = 0.f;
#pragma unroll
                for (int bj = 0; bj < 2; ++bj) { f32x4 b0, b1;
                    if (BF16BASE) { const u32x4 bw = *(const u32x4*)(hb + off + bj * HALF); b0 = (f32x4){bflo(bw.x), bfhi(bw.x), bflo(bw.y), bfhi(bw.y)}; b1 = (f32x4){bflo(bw.z), bfhi(bw.z), bflo(bw.w), bfhi(bw.w)}; }
                    else { b0 = *(const f32x4*)(base + off + bj * HALF); b1 = *(const f32x4*)(base + off + bj * HALF + 4); }
                    const f32x4 v0 = b0 + acc[ai][bj][m][0], v1 = b1 + acc[ai][bj][m][1];
                    u32x4 w; w.x = cvt_pk_bf16(v0[0], v0[1]); w.y = cvt_pk_bf16(v0[2], v0[3]); w.z = cvt_pk_bf16(v1[0], v1[1]); w.w = cvt_pk_bf16(v1[2], v1[3]);
                    *(u32x4*)(hb + off + bj * HALF) = w;
                    s += (v0[0] * v0[0] + v0[1] * v0[1]) + (v0[2] * v0[2] + v0[3] * v0[3]) + (v1[0] * v1[0] + v1[1] * v1[1]) + (v1[2] * v1[2] + v1[3] * v1[3]); }
                s += __shfl_xor(s, 16); s += __shfl_xor(s, 32);
                if (fq == 0) unsafeAtomicAdd(ss + row, s);
                asm volatile("" ::: "memory"); }
    }
};
struct EpiSwiglu {
    static constexpr bool PERM = true, LDSBIAS = true; const PG8_LAS float* slot;
    unsigned char* H; const float* bgu; const float* lrs;
    __device__ __forceinline__ void prefetch(const Unit& u, PG8_LAS unsigned* dst, int lane) const {
        const __amdgpu_buffer_rsrc_t r = __builtin_amdgcn_make_buffer_rsrc((void*)bgu, (short)0, NE * 2048 * 4, 0x00020000);
        __builtin_amdgcn_raw_ptr_buffer_load_lds(r, dst, 16, (unsigned)((lane & 31) * 16 + (lane >> 5) * 4096), (unsigned)(u.e * 2048 + u.pn * HALF) * 4u, 0, 0); }
    __device__ __forceinline__ void operator()(const f32x4 (&acc)[2][2][4][2], const Unit& u, int wr, int wc, int fr, int fq) const {
        const int hc0 = u.pn * HALF + wc * 32 + 8 * fq;
        f32x4 bg[2], bu[2];
#pragma unroll
        for (int n = 0; n < 2; ++n) { bg[n] = *(const PG8_LAS f32x4*)(slot + wc * 32 + 8 * fq + 4 * n); bu[n] = *(const PG8_LAS f32x4*)(slot + 128 + wc * 32 + 8 * fq + 4 * n); }
        const bool odd = (fq & 1) != 0;
#pragma unroll
        for (int ai = 0; ai < 2; ++ai)
#pragma unroll
            for (int m0 = 0; m0 < 4; m0 += 2) { u32x2 w8[2];
#pragma unroll
                for (int mm = 0; mm < 2; ++mm) { const int m = m0 + mm; float hv[8];
#pragma unroll
                    for (int n = 0; n < 2; ++n) { const f32x4 gv = acc[ai][0][m][n] * W8_INV + bg[n], uv = acc[ai][1][m][n] * W8_INV + bu[n];
#pragma unroll
                        for (int j = 0; j < 4; j += 2) {
                            f32x2 g2, u2; g2.x = fminf(gv[j], 7.0f); g2.y = fminf(gv[j + 1], 7.0f); u2.x = __builtin_amdgcn_fmed3f(uv[j], -7.0f, 7.0f); u2.y = __builtin_amdgcn_fmed3f(uv[j + 1], -7.0f, 7.0f);
                            const f32x2 t2 = g2 * (-1.702f * 1.44269504f); f32x2 e2; e2.x = __builtin_amdgcn_exp2f(t2.x); e2.y = __builtin_amdgcn_exp2f(t2.y);
                            const f32x2 d2 = e2 + 1.0f; f32x2 r2; r2.x = __builtin_amdgcn_rcpf(d2.x); r2.y = __builtin_amdgcn_rcpf(d2.y);
                            const f32x2 h2 = ((u2 + 1.0f) * g2) * r2; hv[4 * n + j] = h2.x; hv[4 * n + j + 1] = h2.y; } }
                    w8[mm].x = pk4_fp8(hv[0], hv[1], hv[2], hv[3]); w8[mm].y = pk4_fp8(hv[4], hv[5], hv[6], hv[7]); }
                const unsigned sx = odd ? w8[0].x : w8[1].x, sy = odd ? w8[0].y : w8[1].y;
                const unsigned rx = (unsigned)__builtin_amdgcn_ds_swizzle((int)sx, 0x401F), ry = (unsigned)__builtin_amdgcn_ds_swizzle((int)sy, 0x401F);
                u32x4 o; o.x = odd ? rx : w8[0].x; o.y = odd ? ry : w8[0].y; o.z = odd ? w8[1].x : rx; o.w = odd ? w8[1].y : ry;
                const int rl = ai * HALF + wr * 64 + (m0 + (odd ? 1 : 0)) * 16 + fr;
                *(u32x4*)(H + (size_t)(u.pm * BM + rl) * D + hc0 - (odd ? 8 : 0)) = o; }
    }
};
}

__device__ __forceinline__ void moe_prefix(const int* counts, int lane, int& tend, int& cnt, int& NT) {
    cnt = lane < NE ? counts[lane] : 0;
    int t = (cnt + 255) >> 8;
#pragma unroll
    for (int o = 1; o < 32; o <<= 1) { const int v = __shfl_up(t, o); if ((lane & 31) >= o) t += v; }
    NT = __builtin_amdgcn_readlane(t, 31);
    tend = lane < NE ? t : 0x7fffffff;
}
template <int NCSHIFT> struct MoeOrder {
    int G, vc, NT; const LAS int* tab; __amdgpu_buffer_rsrc_t rl;
    __device__ __forceinline__ bool next(int i, pg8::Unit& u) const {
        const long L = (long)i * G + vc; if (L >= ((long)NT << NCSHIFT)) return false;
        const int rt = (int)(L >> NCSHIFT), cb = (int)(L & ((1 << NCSHIFT) - 1));
        const int lane_ = lane_id(); const int tend = tab[lane_], cnt = tab[64 + lane_];
        const unsigned long long mask = __ballot(tend <= rt);
        const int e = __builtin_amdgcn_readfirstlane(__popcll(mask));
        const int ts = e ? __builtin_amdgcn_readlane(tend, e - 1) : 0;
        u.pm = rt; u.pn = cb; u.pb = (e << NCSHIFT) + cb; u.e = e; u.r0 = (rt - ts) * 256; u.ne = __builtin_amdgcn_readlane(cnt, e);
        return true;
    }
    __device__ __forceinline__ int row_tok(const pg8::Unit& u, int R) const { const int pos = u.r0 + R; const int pc = pos < ECAP ? pos : ECAP - 1;
        const int t = __builtin_amdgcn_raw_buffer_load_b32(rl, (u.e * ECAP + pc) * 4, 0, 0); return pos < u.ne ? t : 0; }
};

#define XB_TMO      128
#define XB_XCNT(j)  (256  + 64 * (j))
#define XB_XSUB(j)  (1280 + 64 * (j))
#define XB_XGEN(j)  (2304 + 64 * (j))
#define XB_TOP      3328
#define XB_TOPGEN   3392
#define XCD_BAR_WORDS 3456
#define XB_SPIN_CAP (1u << 22)
__device__ __forceinline__ unsigned xb_ld(unsigned* p)              { return __hip_atomic_load(p, __ATOMIC_RELAXED, __HIP_MEMORY_SCOPE_AGENT); }
__device__ __forceinline__ unsigned xb_add(unsigned* p, unsigned v) { return __hip_atomic_fetch_add(p, v, __ATOMIC_RELAXED, __HIP_MEMORY_SCOPE_AGENT); }
__device__ __forceinline__ unsigned xb_xcc_id() { return (unsigned)__builtin_amdgcn_s_getreg((3 << 11) | 20) & 0xFu; }
#define XB_SPIN(cond, bar) do { unsigned _sp = 0; while (cond) { __builtin_amdgcn_s_sleep(1); \
    if ((++_sp & 255u) == 0u) { if (xb_ld(&(bar)[XB_TMO])) break; if (_sp > XB_SPIN_CAP) { atomicAdd(&(bar)[XB_TMO], 1u); break; } } } } while (0)
struct XcdBarrier { unsigned* bar; unsigned x; volatile LAS unsigned* st; };
__device__ __forceinline__ XcdBarrier xcd_barrier_post(unsigned* bar, volatile LAS unsigned* st, bool leader) {
    XcdBarrier b; b.bar = bar; b.x = xb_xcc_id(); b.st = st;
    if (leader) (void)xb_add(&bar[XB_XCNT(b.x)], 1u);
    return b;
}
__device__ __forceinline__ void xcd_barrier_complete(unsigned* bar, unsigned x, unsigned& nloc, unsigned& nx) {
    const unsigned G = gridDim.x * gridDim.y * gridDim.z;
    unsigned sum, cnt, mine, sp = 0u;
    for (;;) {
        sum = 0u; cnt = 0u; mine = 0u;
#pragma unroll
        for (unsigned j = 0; j < 16; ++j) { const unsigned c = xb_ld(&bar[XB_XCNT(j)]); sum += c; cnt += (c > 0u) ? 1u : 0u; mine = (j == x) ? c : mine; }
        if (sum == G) break;
        __builtin_amdgcn_s_sleep(1);
        if ((++sp & 255u) == 0u) { if (xb_ld(&bar[XB_TMO])) break; if (sp > XB_SPIN_CAP) { atomicAdd(&bar[XB_TMO], 1u); break; } }
    }
    nloc = mine > 0u ? mine : 1u; nx = cnt > 0u ? cnt : 1u;
}
__device__ __forceinline__ void xcd_barrier(const XcdBarrier& b, bool leader) {
    asm volatile("s_waitcnt vmcnt(0)" ::: "memory");
    __syncthreads();
    if (leader) {
        unsigned* bar = b.bar;
        __builtin_amdgcn_s_waitcnt(0);
        unsigned nloc = b.st[0], nx = b.st[1];
        if (nloc == 0u) { xcd_barrier_complete(bar, b.x, nloc, nx); b.st[0] = nloc; b.st[1] = nx; }
        const unsigned old = xb_add(&bar[XB_XSUB(b.x)], 1u);
        const unsigned gen = old / nloc;
        if (old + 1u == (gen + 1u) * nloc) {
            __builtin_amdgcn_fence(__ATOMIC_RELEASE, "agent");
            asm volatile("s_waitcnt vmcnt(0)" ::: "memory");
            const unsigned og = xb_add(&bar[XB_TOP], 1u);
            const unsigned tg = og / nx;
            if (og + 1u == (tg + 1u) * nx) xb_add(&bar[XB_TOPGEN], 1u);
            else XB_SPIN(xb_ld(&bar[XB_TOPGEN]) == tg, bar);
            __builtin_amdgcn_fence(__ATOMIC_ACQUIRE, "agent");
            xb_add(&bar[XB_XGEN(b.x)], 1u);
            asm volatile("s_waitcnt vmcnt(0)" ::: "memory");
        } else {
            XB_SPIN(xb_ld(&bar[XB_XGEN(b.x)]) == gen, bar);
            __builtin_amdgcn_fence(__ATOMIC_ACQUIRE, "agent");
            asm volatile("s_waitcnt vmcnt(0)" ::: "memory");
        }
    }
    __syncthreads();
}

struct Args { const float* in[35]; float* out; unsigned char* ws; int ph_lo, ph_hi; };

__device__ __forceinline__ void transpose_tile(const float* Wblk, int N, bf16_t* dst, int Kd, const float* gain, LAS float* scr, int lane, int fp8) {
    float v[64];
#pragma unroll
    for (int k = 0; k < 64; ++k) v[k] = Wblk[(size_t)k * N + lane];
    if (gain) {
#pragma unroll
        for (int k = 0; k < 64; ++k) v[k] *= gain[k]; }
#pragma unroll
    for (int k = 0; k < 64; ++k) scr[k * 65 + lane] = v[k];
    LDS_WAIT(); asm volatile("" ::: "memory");
    if (fp8) { const int c4 = lane & 3; unsigned char* d8 = (unsigned char*)dst;
#pragma unroll
        for (int j = 0; j < 4; ++j) { const int n = (lane >> 2) + 16 * j; const LAS float* s = scr + (16 * c4) * 65 + n; u32x4 o;
            o.x = pk4_fp8(s[0 * 65] * W8_SCALE, s[1 * 65] * W8_SCALE, s[2 * 65] * W8_SCALE, s[3 * 65] * W8_SCALE); o.y = pk4_fp8(s[4 * 65] * W8_SCALE, s[5 * 65] * W8_SCALE, s[6 * 65] * W8_SCALE, s[7 * 65] * W8_SCALE);
            o.z = pk4_fp8(s[8 * 65] * W8_SCALE, s[9 * 65] * W8_SCALE, s[10 * 65] * W8_SCALE, s[11 * 65] * W8_SCALE); o.w = pk4_fp8(s[12 * 65] * W8_SCALE, s[13 * 65] * W8_SCALE, s[14 * 65] * W8_SCALE, s[15 * 65] * W8_SCALE);
            *(u32x4*)(d8 + (size_t)n * Kd + 16 * c4) = o; }
        LDS_WAIT(); asm volatile("" ::: "memory"); return; }
    const int c = lane & 7;
#pragma unroll
    for (int j = 0; j < 8; ++j) { const int n = (lane >> 3) + 8 * j; const LAS float* s = scr + (8 * c) * 65 + n;
        u32x4 o; o.x = pk2(s[0 * 65], s[1 * 65]); o.y = pk2(s[2 * 65], s[3 * 65]); o.z = pk2(s[4 * 65], s[5 * 65]); o.w = pk2(s[6 * 65], s[7 * 65]);
        *(u32x4*)(dst + (size_t)n * Kd + 8 * c) = o; }
    LDS_WAIT(); asm volatile("" ::: "memory");
}
__device__ __forceinline__ void rms_row_to_bf16(const float* xrow, bf16_t* orow, int lane) {
    const f32x4* xr = (const f32x4*)xrow + lane;
    f32x4 v[4]; float s = 0.f;
#pragma unroll
    for (int j = 0; j < 4; ++j) { v[j] = xr[64 * j]; s += (v[j].x * v[j].x + v[j].y * v[j].y) + (v[j].z * v[j].z + v[j].w * v[j].w); }
    const float rs = rsqrtf(wave_sum(s) * (1.f / D) + NORM_EPS);
    u32x2* o8 = (u32x2*)orow + lane;
#pragma unroll
    for (int j = 0; j < 4; ++j) { u32x2 w; w.x = pk2(v[j].x * rs, v[j].y * rs); w.y = pk2(v[j].z * rs, v[j].w * rs); o8[64 * j] = w; }
}
__device__ __forceinline__ void rms_2rows_to_bf16(const float* xrow, bf16_t* orow, int lane) {
    const f32x4* xr = (const f32x4*)xrow + lane;
    f32x4 v[8]; float s0 = 0.f, s1 = 0.f;
#pragma unroll
    for (int j = 0; j < 8; ++j) v[j] = xr[64 * j];
#pragma unroll
    for (int j = 0; j < 4; ++j) { s0 += (v[j].x * v[j].x + v[j].y * v[j].y) + (v[j].z * v[j].z + v[j].w * v[j].w); s1 += (v[4 + j].x * v[4 + j].x + v[4 + j].y * v[4 + j].y) + (v[4 + j].z * v[4 + j].z + v[4 + j].w * v[4 + j].w); }
    const float r0 = rsqrtf(wave_sum(s0) * (1.f / D) + NORM_EPS), r1 = rsqrtf(wave_sum(s1) * (1.f / D) + NORM_EPS);
    u32x2* o8 = (u32x2*)orow + lane;
#pragma unroll
    for (int j = 0; j < 8; ++j) { const float rs = j < 4 ? r0 : r1; u32x2 w; w.x = pk2(v[j].x * rs, v[j].y * rs); w.y = pk2(v[j].z * rs, v[j].w * rs); o8[64 * j] = w; }
}
__device__ __forceinline__ void sincos_red(float ang, float& c, float& s) {
    const float k = rintf(ang * 0.15915494309189535f);
    float r = fmaf(-k, 6.2831854820251465f, ang); r = fmaf(-k, -1.7484555e-7f, r);
    c = __cosf(r); s = __sinf(r);
}

constexpr int NWAVES = 8;
constexpr int N_PHASES = 14;

__global__ void __launch_bounds__(NWAVES * 64, 2) hymba_fwd(Args args) {
    extern __shared__ __attribute__((aligned(16))) unsigned char lds_raw[];
    LAS unsigned char* lds = (LAS unsigned char*)lds_raw;
    volatile LAS unsigned* MISC = (volatile LAS unsigned*)(lds + MISC_OFF);
    const int tid = threadIdx.x, lane = tid & 63, wave = __builtin_amdgcn_readfirstlane(tid >> 6), fr = lane & 15, fq = lane >> 4;
    const int G = gridDim.x, bx = blockIdx.x;
    const int vcu = (G % 8 == 0) ? (bx % 8) * (G / 8) + bx / 8 : bx;
    const int gw = vcu * NWAVES + wave, NGW = G * NWAVES;
    unsigned char* ws = args.ws;
    unsigned* ctl = (unsigned*)(ws + WS_CTL);
    typedef const float* cfp_t;
    const __attribute__((address_space(4))) cfp_t* kargs0 = (const __attribute__((address_space(4))) cfp_t*)__builtin_amdgcn_kernarg_segment_ptr();
    float* OUT = args.out;
    for (int u = tid; u < (LDS_BYTES - RING_BYTES) / 4; u += NWAVES * 64) ((LAS unsigned*)(lds + RING_BYTES))[u] = 0u;
    __syncthreads();
    XcdBarrier bar; bar.bar = ctl + CW_BAR; bar.x = 0; bar.st = nullptr;
    if (MK_N_LAUNCHES == 1) bar = xcd_barrier_post(ctl + CW_BAR, MISC + 8, tid == 0);
    const int lo = args.ph_lo, hi = args.ph_hi;
#define IN(k) (lo <= (k) && (k) < hi)
#define PHASE_IDS() int tid = wave * 64 + lane_id(); asm volatile("" : "+v"(tid)); const int lane = tid & 63, fr = lane & 15, fq = lane >> 4; (void)fr; (void)fq; \
    const __attribute__((address_space(4))) cfp_t* ka = kargs0; asm volatile("" : "+s"(ka)); GAS unsigned char* wsl = (GAS unsigned char*)ws; asm volatile("" : "+s"(wsl)); (void)ka; (void)wsl
#define SEAM(k) do { if (IN(k) && IN((k) + 1)) xcd_barrier(bar, wave == 0 && lane_id() == 0); } while (0)

    if (IN(0)) { PHASE_IDS();
        LAS float* scr = (LAS float*)(lds + wave * 16640);
        constexpr int I_IN = 16 * 24, I_SQ = 16 * 16, I_KV = 16 * 32, I_GU = 16 * 32, I_DN = 16 * 16;
        constexpr int E0 = I_IN, E1 = E0 + I_SQ, E2 = E1 + I_SQ, E3 = E2 + I_SQ, E4 = E3 + I_KV, E6 = E4 + 16, E7 = E6 + NE * I_GU, E8 = E7 + NE * I_DN;
        for (int it = gw; it < E8; it += NGW) {
            const float* W; const float* gain = nullptr; bf16_t* dstm; int K = 1024, N, r; int rowmap = 0, f8 = 0;
            if (it < E0) { W = ((const float*)(const GAS float*)(ka[3])); N = NPROJ; gain = ((const float*)(const GAS float*)(ka[2])); dstm = ((bf16_t*)(GAS bf16_t*)(wsl + WS_WIN)); r = it; }
            else if (it < E1) { W = ((const float*)(const GAS float*)(ka[21])); N = D; dstm = ((bf16_t*)(GAS bf16_t*)(wsl + WS_WOUT)); r = it - E0; }
            else if (it < E2) { W = ((const float*)(const GAS float*)(ka[24])); N = D; gain = ((const float*)(const GAS float*)(ka[22])); dstm = ((bf16_t*)(GAS bf16_t*)(wsl + WS_WQ)); r = it - E1; }
            else if (it < E3) { W = ((const float*)(const GAS float*)(ka[26])); N = D; dstm = ((bf16_t*)(GAS bf16_t*)(wsl + WS_WO)); r = it - E2; }
            else if (it < E4) { W = ((const float*)(const GAS float*)(ka[25])); N = 2 * D; gain = ((const float*)(const GAS float*)(ka[23])); dstm = ((bf16_t*)(GAS bf16_t*)(wsl + WS_WKV)); r = it - E3; }
            else if (it < E6) { const int q = it - E4, mat = q >> 3, hh = q & 7; r = 0; K = 64; N = 64;
                W = (mat ? ((const float*)(const GAS float*)(ka[8])) : ((const float*)(const GAS float*)(ka[6]))) + (size_t)hh * 4096; dstm = ((bf16_t*)(GAS bf16_t*)(wsl + WS_RGWT)) + (size_t)(mat * 8 + hh) * 4096; }
            else if (it < E7) { const int q = it - E6, e = q / I_GU; r = q % I_GU; N = 2 * D; gain = ((const float*)(const GAS float*)(ka[27])); rowmap = 1; f8 = 1;
                W = ((const float*)(const GAS float*)(ka[30])) + (size_t)e * D * 2 * D; dstm = (bf16_t*)((unsigned char*)((bf16_t*)(GAS bf16_t*)(wsl + WS_WGU)) + (size_t)e * 2 * D * D); }
            else { const int q = it - E7, e = q / I_DN; r = q % I_DN; N = D; f8 = 1; W = ((const float*)(const GAS float*)(ka[32])) + (size_t)e * D * D; dstm = (bf16_t*)((unsigned char*)((bf16_t*)(GAS bf16_t*)(wsl + WS_WDN)) + (size_t)e * D * D); }
            const int nblk = N / 64, kb = r / nblk, nb = r % nblk, k0 = 64 * kb, n0 = 64 * nb;
            int dn0 = n0; if (rowmap) dn0 = ((n0 & 1023) >> 7) * 256 + (n0 >> 10) * 128 + (n0 & 127);
            bf16_t* dptr = f8 ? (bf16_t*)((unsigned char*)dstm + (size_t)dn0 * K + k0) : dstm + (size_t)dn0 * K + k0;
            transpose_tile(W + (size_t)k0 * N + n0, N, dptr, K, gain ? gain + k0 : nullptr, scr, lane, f8);
        }
        for (int m = 2 * gw; m < M; m += 2 * NGW) rms_2rows_to_bf16(((const float*)(const GAS float*)(ka[0])) + (size_t)m * D, ((bf16_t*)(GAS bf16_t*)(wsl + WS_XB)) + (size_t)m * D, lane);
        for (int m = gw; m < BATCH * MEMLEN; m += NGW) rms_row_to_bf16(((const float*)(const GAS float*)(ka[1])) + (size_t)m * D, ((bf16_t*)(GAS bf16_t*)(wsl + WS_MEMB)) + (size_t)m * D, lane);
        const int gt = bx * (NWAVES * 64) + tid, NT_ = G * NWAVES * 64;
        for (int i = gt; i < NE * D; i += NT_) { const int n = i >> 10, k = i & 1023; ((bf16_t*)(GAS bf16_t*)(wsl + WS_WRT))[i] = f2bf(((const float*)(const GAS float*)(ka[28]))[(size_t)k * NE + n] * ((const float*)(const GAS float*)(ka[27]))[k]); }
        for (int i = gt; i < 512; i += NT_) { const float l = -((const float*)(const GAS float*)(ka[10]))[i]; ((float*)(GAS float*)(wsl + WS_SP8))[i] = 8.f * (fmaxf(l, 0.f) + log1pf(__expf(-fabsf(l)))); }
        for (int i = gt; i < NE * 64; i += NT_) { const int g = i >> 6; const float dt = __expf(((const float*)(const GAS float*)(ka[18]))[g]), lre = ((const float*)(const GAS float*)(ka[11]))[i], lim = ((const float*)(const GAS float*)(ka[12]))[i];
            float c, s; sincos_red(dt * lim, c, s); const float mg = __expf(dt * lre); ((float*)(GAS float*)(wsl + WS_S5A))[2 * i] = mg * c; ((float*)(GAS float*)(wsl + WS_S5A))[2 * i + 1] = mg * s;
            sincos_red((float)S5_TCH * (dt * lim), c, s); const float mgl = __expf((float)S5_TCH * dt * lre); ((float*)(GAS float*)(wsl + WS_S5AL))[2 * i] = mgl * c; ((float*)(GAS float*)(wsl + WS_S5AL))[2 * i + 1] = mgl * s; }
        for (int i = gt; i < NE * 128 * 32; i += NT_) { const int k = i & 31, n = (i >> 5) & 127, g = i >> 12, p = n & 63; float v = 0.f;
            if (k < 16) { const int gp = g * 64 + p; const float dt = __expf(((const float*)(const GAS float*)(ka[18]))[g]), lre = ((const float*)(const GAS float*)(ka[11]))[gp], lim = ((const float*)(const GAS float*)(ka[12]))[gp];
                float c, s; sincos_red(dt * lim, c, s); const float xr = dt * lre, em1 = expm1f(xr), sh = __sinf(0.5f * (dt * lim - 6.2831853f * rintf(dt * lim * 0.15915494f)));
                const float mg = em1 + 1.f; const float nre = em1 * c - 2.f * sh * sh, aim = mg * s;
                const float den = lre * lre + lim * lim; const float cre = (nre * lre + aim * lim) / den, cim = (aim * lre - nre * lim) / den;
                const float br = ((const float*)(const GAS float*)(ka[13]))[(size_t)gp * 16 + k], bi = ((const float*)(const GAS float*)(ka[14]))[(size_t)gp * 16 + k];
                v = (n < 64) ? (cre * br - cim * bi) : (cre * bi + cim * br); }
            ((bf16_t*)(GAS bf16_t*)(wsl + WS_S5BT))[i] = f2bf(v); }
        for (int i = gt; i < NE * 16 * 128; i += NT_) { const int n = i & 127, c = (i >> 7) & 15, g = i >> 11;
            const float v = (n < 64) ? ((const float*)(const GAS float*)(ka[15]))[(size_t)(g * 16 + c) * 64 + n] : -((const float*)(const GAS float*)(ka[16]))[(size_t)(g * 16 + c) * 64 + (n - 64)]; ((bf16_t*)(GAS bf16_t*)(wsl + WS_S5CT))[i] = f2bf(v); }
        for (int i = gt; i < NE * 16 * 32; i += NT_) { const int ks = i & 31, d = (i >> 5) & 15, g = i >> 9, q = ks >> 3, j = ks & 7;
            const float v = (j < 4) ? ((const float*)(const GAS float*)(ka[19]))[(size_t)(g * 16 + 4 * q + j) * 16 + d] : 0.f; ((bf16_t*)(GAS bf16_t*)(wsl + WS_S5GT))[i] = f2bf(v); }
    }
    SEAM(0);

    if (IN(1)) { PHASE_IDS();
        { pg8::Gemm g{((bf16_t*)(GAS bf16_t*)(wsl + WS_XB)), ((bf16_t*)(GAS bf16_t*)(wsl + WS_WIN)), 2 * D}; pg8::StaticOrder S; S.init(M, NPROJ, G, bx); pg8::EpiBf16<0> E{nullptr, ((bf16_t*)(GAS bf16_t*)(wsl + WS_PROJ)), NPROJ, nullptr, 1.f};
          pg8::gemm_phase<pg8::EpiBf16<0>, pg8::StaticOrder, false, true>(lds, g, S, E, wave); }
    }
    SEAM(1);

#define WLB() do { asm volatile("s_waitcnt lgkmcnt(0)" ::: "memory"); } while (0)
#define RG_PART(FINAL) do { \
      LAS unsigned char* wl = lds + wave * 12800; LAS bf16_t* XC = (LAS bf16_t*)wl; LAS float* RT = (LAS float*)(wl + 2304); LAS float* IT = (LAS float*)(wl + 6656); (void)XC; (void)IT; \
      const int ch = wave * 64 + lane, h = wave; \
      if (FINAL) {   \
        for (int item = bx; item < BATCH * RG_NCH; item += G) { \
          const int b = item / RG_NCH, c = item % RG_NCH; const size_t row0 = (size_t)b * SEQ + c * RG_TCH; \
          float hst = ((float*)(GAS float*)(wsl + WS_RGHIN))[(size_t)item * 512 + ch]; \
          unsigned abn[16]; bf16_t gn_[16]; \
          _Pragma("unroll") for (int i = 0; i < 16; ++i) { abn[i] = ((unsigned*)(GAS unsigned*)(wsl + WS_QB))[(row0 + i) * 512 + ch]; gn_[i] = ((bf16_t*)(GAS bf16_t*)(wsl + WS_PROJ))[(row0 + i) * NPROJ + ch]; } \
          for (int sub = 0; sub < 8; ++sub) { \
              const size_t rb = row0 + 16 * sub; LAS bf16_t* YB = (LAS bf16_t*)wl; \
              unsigned ab[16]; float gt_[16]; \
              _Pragma("unroll") for (int i = 0; i < 16; ++i) { ab[i] = abn[i]; gt_[i] = bf2f(gn_[i]); } \
              if (sub < 7) { _Pragma("unroll") for (int i = 0; i < 16; ++i) { abn[i] = ((unsigned*)(GAS unsigned*)(wsl + WS_QB))[(rb + 16 + i) * 512 + ch]; gn_[i] = ((bf16_t*)(GAS bf16_t*)(wsl + WS_PROJ))[(rb + 16 + i) * NPROJ + ch]; } } \
              _Pragma("unroll") for (int i = 0; i < 16; i += 2) { \
                  f32x2 a2; a2.x = __builtin_amdgcn_exp2f(bflo(ab[i])); a2.y = __builtin_amdgcn_exp2f(bflo(ab[i + 1])); \
                  hst = a2.x * hst + bfhi(ab[i]); const float h0 = hst; hst = a2.y * hst + bfhi(ab[i + 1]); const float h1 = hst; \
                  f32x2 gt2; gt2.x = gt_[i]; gt2.y = gt_[i + 1]; const f32x2 q2 = (gt2 + (gt2 * gt2) * gt2 * 0.044715f) * (-1.5957691216057308f * 1.44269504f); \
                  f32x2 eq; eq.x = __builtin_amdgcn_exp2f(q2.x); eq.y = __builtin_amdgcn_exp2f(q2.y); const f32x2 dq = eq + 1.0f; \
                  YB[i * 72 + lane] = f2bf(h0 * gt2.x * __builtin_amdgcn_rcpf(dq.x)); YB[(i + 1) * 72 + lane] = f2bf(h1 * gt2.y * __builtin_amdgcn_rcpf(dq.y)); } \
              WLB(); \
              _Pragma("unroll") for (int j = 0; j < 2; ++j) { const int p = lane + 64 * j, yr = p >> 3, yc = (p & 7) * 8; \
                  *(u32x4*)(((bf16_t*)(GAS bf16_t*)(wsl + WS_YCAT)) + (rb + yr) * D + h * 64 + yc) = *(const LAS u32x4*)(YB + yr * 72 + yc); } \
              WLB(); \
          } } } \
      else { \
      const float cw0 = ((const float*)(const GAS float*)(ka[4]))[ch], cw1 = ((const float*)(const GAS float*)(ka[4]))[512 + ch], cw2 = ((const float*)(const GAS float*)(ka[4]))[1024 + ch], cw3 = ((const float*)(const GAS float*)(ka[4]))[1536 + ch], cbias = ((const float*)(const GAS float*)(ka[5]))[ch]; \
      const float ba = ((const float*)(const GAS float*)(ka[7]))[ch], bxx = ((const float*)(const GAS float*)(ka[9]))[ch], ksp = -1.44269504f * ((float*)(GAS float*)(wsl + WS_SP8))[ch]; \
      bf16x8 wa[4][2], wx[4][2]; \
      _Pragma("unroll") for (int nt = 0; nt < 4; ++nt) _Pragma("unroll") for (int ks = 0; ks < 2; ++ks) { \
          wa[nt][ks] = *(const bf16x8*)(((bf16_t*)(GAS bf16_t*)(wsl + WS_RGWT)) + (size_t)(h * 64 + 16 * nt + fr) * 64 + 32 * ks + 8 * fq); \
          wx[nt][ks] = *(const bf16x8*)(((bf16_t*)(GAS bf16_t*)(wsl + WS_RGWT)) + (size_t)((8 + h) * 64 + 16 * nt + fr) * 64 + 32 * ks + 8 * fq); } \
      for (int item = bx; item < BATCH * RG_NCH; item += G) { \
          const int b = item / RG_NCH, c = item % RG_NCH, t0 = c * RG_TCH; const size_t row0 = (size_t)b * SEQ + t0; \
          float xm3 = 0.f, xm2 = 0.f, xm1 = 0.f; \
          if (t0 > 0) { xm3 = bf2f(((bf16_t*)(GAS bf16_t*)(wsl + WS_PROJ))[(row0 - 3) * NPROJ + 512 + ch]); xm2 = bf2f(((bf16_t*)(GAS bf16_t*)(wsl + WS_PROJ))[(row0 - 2) * NPROJ + 512 + ch]); xm1 = bf2f(((bf16_t*)(GAS bf16_t*)(wsl + WS_PROJ))[(row0 - 1) * NPROJ + 512 + ch]); } \
          float hst = 0.f, pacc = 1.f; \
          bf16_t xn_[16]; \
          _Pragma("unroll") for (int i = 0; i < 16; ++i) xn_[i] = ((bf16_t*)(GAS bf16_t*)(wsl + WS_PROJ))[(row0 + i) * NPROJ + 512 + ch]; \
          for (int sub = 0; sub < 8; ++sub) { \
              const size_t rb = row0 + 16 * sub; \
              float xr[16], xc[16]; \
              _Pragma("unroll") for (int i = 0; i < 16; ++i) xr[i] = bf2f(xn_[i]); \
              if (sub < 7) { _Pragma("unroll") for (int i = 0; i < 16; ++i) xn_[i] = ((bf16_t*)(GAS bf16_t*)(wsl + WS_PROJ))[(rb + 16 + i) * NPROJ + 512 + ch]; } \
              _Pragma("unroll") for (int i = 0; i < 16; ++i) { xc[i] = cw0 * xm3 + cw1 * xm2 + cw2 * xm1 + cw3 * xr[i] + cbias; xm3 = xm2; xm2 = xm1; xm1 = xr[i]; XC[i * 72 + lane] = f2bf(xc[i]); } \
              WLB(); \
              { const bf16x8 a0 = *(const LAS bf16x8*)(XC + fr * 72 + 8 * fq), a1 = *(const LAS bf16x8*)(XC + fr * 72 + 32 + 8 * fq); \
                _Pragma("unroll") for (int nt = 0; nt < 4; ++nt) { f32x4 r = {0.f, 0.f, 0.f, 0.f}, q = {0.f, 0.f, 0.f, 0.f}; \
                    r = __builtin_amdgcn_mfma_f32_16x16x32_bf16(wa[nt][0], a0, r, 0, 0, 0); r = __builtin_amdgcn_mfma_f32_16x16x32_bf16(wa[nt][1], a1, r, 0, 0, 0); \
                    q = __builtin_amdgcn_mfma_f32_16x16x32_bf16(wx[nt][0], a0, q, 0, 0, 0); q = __builtin_amdgcn_mfma_f32_16x16x32_bf16(wx[nt][1], a1, q, 0, 0, 0); \
                    *(LAS f32x4*)(RT + fr * 68 + 16 * nt + 4 * fq) = r; *(LAS f32x4*)(IT + fr * 68 + 16 * nt + 4 * fq) = q; } } \
              WLB(); \
              _Pragma("unroll") for (int i = 0; i < 16; i += 2) {   \
                  f32x2 rp, ip; rp.x = RT[i * 68 + lane]; rp.y = RT[(i + 1) * 68 + lane]; ip.x = IT[i * 68 + lane]; ip.y = IT[(i + 1) * 68 + lane]; \
                  const f32x2 tr = (rp + ba) * (-1.44269504f), ti = (ip + bxx) * (-1.44269504f); \
                  f32x2 er, ei; er.x = __builtin_amdgcn_exp2f(tr.x); er.y = __builtin_amdgcn_exp2f(tr.y); ei.x = __builtin_amdgcn_exp2f(ti.x); ei.y = __builtin_amdgcn_exp2f(ti.y); \
                  const f32x2 dr = er + 1.0f, di = ei + 1.0f; \
                  f32x2 r2, g2; r2.x = __builtin_amdgcn_rcpf(dr.x); r2.y = __builtin_amdgcn_rcpf(dr.y); g2.x = __builtin_amdgcn_rcpf(di.x); g2.y = __builtin_amdgcn_rcpf(di.y); \
                  const f32x2 la = r2 * ksp; f32x2 a2; a2.x = __builtin_amdgcn_exp2f(la.x); a2.y = __builtin_amdgcn_exp2f(la.y);     \
                  const f32x2 m2 = 1.0f - a2 * a2; f32x2 mu; mu.x = __builtin_amdgcn_sqrtf(fmaxf(m2.x, 0.f)); mu.y = __builtin_amdgcn_sqrtf(fmaxf(m2.y, 0.f)); \
                  if (t0 + 16 * sub + i == 0) mu.x = 1.f; \
                  f32x2 xc2; xc2.x = xc[i]; xc2.y = xc[i + 1]; const f32x2 b2 = (mu * g2) * xc2; \
                  hst = a2.x * hst + b2.x; hst = a2.y * hst + b2.y; pacc *= a2.x * a2.y; \
                  ((LAS unsigned*)RT)[i * 68 + lane] = pk2(la.x, b2.x); ((LAS unsigned*)RT)[(i + 1) * 68 + lane] = pk2(la.y, b2.y); }     \
              WLB(); \
              _Pragma("unroll") for (int j = 0; j < 4; ++j) { const int p = lane + 64 * j, yr = p >> 4, yc = (p & 15) * 4; \
                  *(u32x4*)(((unsigned*)(GAS unsigned*)(wsl + WS_QB)) + (rb + yr) * 512 + h * 64 + yc) = *(const LAS u32x4*)((LAS unsigned*)RT + yr * 68 + yc); } \
              WLB(); \
          } \
          ((float*)(GAS float*)(wsl + WS_RGP))[(size_t)item * 512 + ch] = pacc; ((float*)(GAS float*)(wsl + WS_RGH))[(size_t)item * 512 + ch] = hst; \
      } } } while (0)
#define S5_PART(FINAL) do { \
    { LAS float* BU = (LAS float*)(lds + wave * 12800); LAS bf16_t* HT = (LAS bf16_t*)(lds + wave * 12800 + 8448); \
      for (int item = gw; item < BATCH * NE * S5_NCH; item += NGW) { \
          const int c = item % S5_NCH, g = (item / S5_NCH) % NE, b = item / (S5_NCH * NE); \
          const float are = ((float*)(GAS float*)(wsl + WS_S5A))[2 * (g * 64 + lane)], aim = ((float*)(GAS float*)(wsl + WS_S5A))[2 * (g * 64 + lane) + 1]; \
          bf16x8 btf[8]; _Pragma("unroll") for (int nt = 0; nt < 8; ++nt) btf[nt] = *(const bf16x8*)(((bf16_t*)(GAS bf16_t*)(wsl + WS_S5BT)) + (size_t)(g * 128 + 16 * nt + fr) * 32 + 8 * fq); \
          bf16x8 ctf[4], gtf; f32x4 dsk, gbv; \
          if (FINAL) { _Pragma("unroll") for (int ks = 0; ks < 4; ++ks) ctf[ks] = *(const bf16x8*)(((bf16_t*)(GAS bf16_t*)(wsl + WS_S5CT)) + (size_t)(g * 16 + fr) * 128 + 32 * ks + 8 * fq); \
              gtf = *(const bf16x8*)(((bf16_t*)(GAS bf16_t*)(wsl + WS_S5GT)) + (size_t)(g * 16 + fr) * 32 + 8 * fq); dsk = *(const f32x4*)(((const float*)(const GAS float*)(ka[17])) + 16 * g + 4 * fq); gbv = *(const f32x4*)(((const float*)(const GAS float*)(ka[20])) + 16 * g + 4 * fq); } \
          float hre = 0.f, him = 0.f; if (FINAL) { hre = ((float*)(GAS float*)(wsl + WS_S5HIN))[(size_t)item * 128 + lane]; him = ((float*)(GAS float*)(wsl + WS_S5HIN))[(size_t)item * 128 + 64 + lane]; } \
          const size_t row0 = (size_t)b * SEQ + (size_t)c * S5_TCH; \
          bf16x8 ufn = {0, 0, 0, 0, 0, 0, 0, 0}; if (fq < 2) ufn = *(const bf16x8*)(((bf16_t*)(GAS bf16_t*)(wsl + WS_PROJ)) + (row0 + fr) * NPROJ + 1024 + 16 * g + 8 * fq); \
          u32x2 urn = {0u, 0u}; if (FINAL) urn = *(const u32x2*)(((bf16_t*)(GAS bf16_t*)(wsl + WS_PROJ)) + (row0 + fr) * NPROJ + 1024 + 16 * g + 4 * fq); \
          for (int it = 0; it < S5_TCH / 16; ++it) { \
              const size_t rb = row0 + 16 * it; \
              const bf16x8 uf = ufn; const u32x2 uraw = urn; \
              if (it + 1 < S5_TCH / 16) { if (fq < 2) ufn = *(const bf16x8*)(((bf16_t*)(GAS bf16_t*)(wsl + WS_PROJ)) + (rb + 16 + fr) * NPROJ + 1024 + 16 * g + 8 * fq); \
                  if (FINAL) urn = *(const u32x2*)(((bf16_t*)(GAS bf16_t*)(wsl + WS_PROJ)) + (rb + 16 + fr) * NPROJ + 1024 + 16 * g + 4 * fq); } \
              _Pragma("unroll") for (int nt = 0; nt < 8; ++nt) { f32x4 a4 = {0.f, 0.f, 0.f, 0.f}; a4 = __builtin_amdgcn_mfma_f32_16x16x32_bf16(btf[nt], uf, a4, 0, 0, 0); \
                  *(LAS f32x4*)(BU + fr * 132 + 16 * nt + 4 * fq) = a4; } \
              LDS_WAIT(); \
              float bre_[16], bim_[16]; \
              _Pragma("unroll") for (int i = 0; i < 16; ++i) { bre_[i] = BU[i * 132 + lane]; bim_[i] = BU[i * 132 + 64 + lane]; } \
              _Pragma("unroll") for (int i = 0; i < 16; ++i) { const float bre = bre_[i], bim = bim_[i]; \
                  const float nr = are * hre - aim * him + bre, ni = are * him + aim * hre + bim; hre = nr; him = ni; \
                  if (FINAL) { HT[i * 136 + lane] = f2bf(nr); HT[i * 136 + 64 + lane] = f2bf(ni); } } \
              if (FINAL) { LDS_WAIT(); \
                  f32x4 y = {0.f, 0.f, 0.f, 0.f}; \
                  _Pragma("unroll") for (int ks = 0; ks < 4; ++ks) { const bf16x8 hf = *(const LAS bf16x8*)(HT + fr * 136 + 32 * ks + 8 * fq); y = __builtin_amdgcn_mfma_f32_16x16x32_bf16(ctf[ks], hf, y, 0, 0, 0); } \
                  f32x4 z; z[0] = gelu_tanh(y[0] + dsk[0] * bflo(uraw.x)); z[1] = gelu_tanh(y[1] + dsk[1] * bfhi(uraw.x)); z[2] = gelu_tanh(y[2] + dsk[2] * bflo(uraw.y)); z[3] = gelu_tanh(y[3] + dsk[3] * bfhi(uraw.y)); \
                  union { bf16x8 v; unsigned w[4]; } zf; zf.w[0] = pk2(z[0], z[1]); zf.w[1] = pk2(z[2], z[3]); zf.w[2] = 0u; zf.w[3] = 0u; \
                  f32x4 gp = {0.f, 0.f, 0.f, 0.f}; gp = __builtin_amdgcn_mfma_f32_16x16x32_bf16(gtf, zf.v, gp, 0, 0, 0); \
                  u32x2 o; o.x = pk2(z[0] * sigmoidf_(gp[0] + gbv[0]), z[1] * sigmoidf_(gp[1] + gbv[1])); o.y = pk2(z[2] * sigmoidf_(gp[2] + gbv[2]), z[3] * sigmoidf_(gp[3] + gbv[3])); \
                  *(u32x2*)(((bf16_t*)(GAS bf16_t*)(wsl + WS_YCAT)) + (rb + fr) * D + 512 + 16 * g + 4 * fq) = o; } \
              LDS_WAIT(); \
          } \
          if (!FINAL) { ((float*)(GAS float*)(wsl + WS_S5H))[(size_t)item * 128 + lane] = hre; ((float*)(GAS float*)(wsl + WS_S5H))[(size_t)item * 128 + 64 + lane] = him; } \
      } } \
} while (0)
#define MIXER_PASS(FINAL) do { PHASE_IDS(); if (wave < 4) { S5_PART(FINAL); RG_PART(FINAL); } else { RG_PART(FINAL); S5_PART(FINAL); } __syncthreads(); } while (0)


    if (IN(2)) { MIXER_PASS(false); }
    SEAM(2);

    if (IN(3)) { PHASE_IDS();
        if (G >= 64 ? bx >= 32 : true) { pg8::Gemm g{((bf16_t*)(GAS bf16_t*)(wsl + WS_MEMB)), ((bf16_t*)(GAS bf16_t*)(wsl + WS_WKV)), 2 * D}; pg8::StaticOrder S; S.init(BATCH * MEMLEN, 2 * D, G >= 64 ? G - 32 : G, G >= 64 ? bx - 32 : bx); pg8::EpiKV E{((bf16_t*)(GAS bf16_t*)(wsl + WS_KB)), ((bf16_t*)(GAS bf16_t*)(wsl + WS_VT))};
          pg8::gemm_phase<pg8::EpiKV, pg8::StaticOrder, false, true>(lds, g, S, E, wave); }
        const int gt = bx * (NWAVES * 64) + tid;
        if (gt < BATCH * 512) { const int b = gt / 512, ch = gt % 512; float h = 0.f;
            for (int c0 = 0; c0 < RG_NCH; c0 += 16) { float pp[16], hh[16];
#pragma unroll
                for (int j = 0; j < 16; ++j) { const size_t idx = (size_t)(b * RG_NCH + c0 + j) * 512 + ch; pp[j] = ((float*)(GAS float*)(wsl + WS_RGP))[idx]; hh[j] = ((float*)(GAS float*)(wsl + WS_RGH))[idx]; }
#pragma unroll
                for (int j = 0; j < 16; ++j) { const size_t idx = (size_t)(b * RG_NCH + c0 + j) * 512 + ch; ((float*)(GAS float*)(wsl + WS_RGHIN))[idx] = h; h = pp[j] * h + hh[j]; } } }
        else if (gt < BATCH * 512 + BATCH * NE * 64) { const int k = gt - BATCH * 512, p = k & 63, g = (k >> 6) & 31, b = k >> 11;
            const float ar = ((float*)(GAS float*)(wsl + WS_S5AL))[2 * (g * 64 + p)], ai = ((float*)(GAS float*)(wsl + WS_S5AL))[2 * (g * 64 + p) + 1]; float hr = 0.f, hi_ = 0.f;
            float lr[S5_NCH], li[S5_NCH];
#pragma unroll
            for (int c = 0; c < S5_NCH; ++c) { const size_t idx = (size_t)((b * NE + g) * S5_NCH + c) * 128 + p; lr[c] = ((float*)(GAS float*)(wsl + WS_S5H))[idx]; li[c] = ((float*)(GAS float*)(wsl + WS_S5H))[idx + 64]; }
#pragma unroll
            for (int c = 0; c < S5_NCH; ++c) { const size_t idx = (size_t)((b * NE + g) * S5_NCH + c) * 128 + p; ((float*)(GAS float*)(wsl + WS_S5HIN))[idx] = hr; ((float*)(GAS float*)(wsl + WS_S5HIN))[idx + 64] = hi_;
                const float nr = ar * hr - ai * hi_ + lr[c], ni = ar * hi_ + ai * hr + li[c]; hr = nr; hi_ = ni; } }
    }
    SEAM(3);

    if (IN(4)) { MIXER_PASS(true); }
    SEAM(4);

    if (IN(5)) { PHASE_IDS(); pg8::Gemm g{((bf16_t*)(GAS bf16_t*)(wsl + WS_YCAT)), ((bf16_t*)(GAS bf16_t*)(wsl + WS_WOUT)), 2 * D}; pg8::StaticOrder S; S.init(M, D, G, bx); pg8::EpiRes<false> E{((const float*)(const GAS float*)(ka[0])), ((bf16_t*)(GAS bf16_t*)(wsl + WS_HB)), ((float*)(GAS float*)(wsl + WS_SS1))};
        pg8::gemm_phase<pg8::EpiRes<false>, pg8::StaticOrder, false, true>(lds, g, S, E, wave); }
    SEAM(5);

    if (IN(6)) { PHASE_IDS(); pg8::Gemm g{((bf16_t*)(GAS bf16_t*)(wsl + WS_HB)), ((bf16_t*)(GAS bf16_t*)(wsl + WS_WQ)), 2 * D}; pg8::StaticOrder S; S.init(M, D, G, bx); pg8::EpiBf16<1> E{nullptr, ((bf16_t*)(GAS bf16_t*)(wsl + WS_QB)), D, ((float*)(GAS float*)(wsl + WS_SS1)), QSCALE};
        pg8::gemm_phase<pg8::EpiBf16<1>, pg8::StaticOrder, false, true>(lds, g, S, E, wave); }
    SEAM(6);

    if (IN(7)) { PHASE_IDS();
        constexpr int NIT = NH * (M / 256), RB = M / 256;
        unsigned dsrc[8];
#pragma unroll
        for (int j = 0; j < 8; ++j) { const int lr = 2 * (wave * 8 + j) + (lane >> 5), p = lane & 31, c = ((p ^ lr) & 15) | (p & 16); dsrc[j] = (unsigned)(lr * 512 + c * 16); }
#define ATT_DMA(rs_, half_, buf_) do { _Pragma("unroll") for (int _j = 0; _j < 8; ++_j) \
            __builtin_amdgcn_raw_ptr_buffer_load_lds(rs_, (LAS unsigned*)(lds + (buf_) + (wave * 8 + _j) * 1024), 16, dsrc[_j], (half_) * 65536, 0, 0); } while (0)
#define ATT_SYNC(wait_) do { if (wait_) asm volatile("s_waitcnt vmcnt(0)" ::: "memory"); asm volatile("s_waitcnt lgkmcnt(0)" ::: "memory"); __builtin_amdgcn_s_barrier(); asm volatile("" ::: "memory"); } while (0)
#define ATT_FRAG(buf_, r_, ci_) (*(const LAS bf16x8*)(lds + (buf_) + (r_) * 512 + ((((ci_) ^ (r_)) & 15) | ((ci_) & 16)) * 16))
        int item = bx;
        if (item < NIT) { const int h = item / RB, b = (item % RB) / (SEQ / 256);
            const __amdgpu_buffer_rsrc_t rK = __builtin_amdgcn_make_buffer_rsrc((void*)(((bf16_t*)(GAS bf16_t*)(wsl + WS_KB)) + (size_t)(b * NH + h) * MEMLEN * HD), (short)0, MEMLEN * HD * 2, 0x00020000);
            ATT_DMA(rK, 0, 0); ATT_DMA(rK, 1, 65536); }
        for (; item < NIT; item += G) {
            const int h = item / RB, rblk = item % RB, b = rblk / (SEQ / 256);
            const __amdgpu_buffer_rsrc_t rV = __builtin_amdgcn_make_buffer_rsrc((void*)(((bf16_t*)(GAS bf16_t*)(wsl + WS_VT)) + (size_t)(b * NH + h) * HD * MEMLEN), (short)0, MEMLEN * HD * 2, 0x00020000);
            const size_t rowg = (size_t)rblk * 256 + wave * 32 + fr;
            bf16x8 pf[2][8]; float inv[2];
            ATT_SYNC(true);
#pragma unroll
            for (int g2 = 0; g2 < 2; ++g2) {
                int ro = 16 * g2; if (g2 == 1) asm volatile("" : "+v"(ro) : "v"(inv[0]));
                bf16x8 qf[8];
#pragma unroll
                for (int ks = 0; ks < 8; ++ks) qf[ks] = *(const bf16x8*)(((bf16_t*)(GAS bf16_t*)(wsl + WS_QB)) + (rowg + ro) * D + h * HD + 32 * ks + 8 * fq);
                f32x4 S[16];
#pragma unroll
                for (int mt = 0; mt < 16; ++mt) { S[mt] = (f32x4){0.f, 0.f, 0.f, 0.f};
                    if (g2 == 1 && mt == 8) { ATT_SYNC(false); ATT_DMA(rV, 0, 0); }
#pragma unroll
                    for (int ks = 0; ks < 8; ++ks) { const bf16x8 kf = ATT_FRAG((mt >> 3) * 65536, 16 * (mt & 7) + fr, 4 * ks + fq); S[mt] = __builtin_amdgcn_mfma_f32_16x16x32_bf16(kf, qf[ks], S[mt], 0, 0, 0); } }
                float mx = -3.0e38f;
#pragma unroll
                for (int mt = 0; mt < 16; ++mt) mx = fmaxf(fmaxf(mx, fmaxf(S[mt][0], S[mt][1])), fmaxf(S[mt][2], S[mt][3]));
                mx = fmaxf(mx, __shfl_xor(mx, 16)); mx = fmaxf(mx, __shfl_xor(mx, 32));
                float sum = 0.f;
#pragma unroll
                for (int k2 = 0; k2 < 8; ++k2) { union { bf16x8 v; unsigned w[4]; } pu; float e[8];
#pragma unroll
                    for (int j = 0; j < 4; ++j) { e[j] = __builtin_amdgcn_exp2f(S[2 * k2][j] - mx); e[4 + j] = __builtin_amdgcn_exp2f(S[2 * k2 + 1][j] - mx); }
                    sum += ((e[0] + e[1]) + (e[2] + e[3])) + ((e[4] + e[5]) + (e[6] + e[7]));
                    pu.w[0] = pk2(e[0], e[1]); pu.w[1] = pk2(e[2], e[3]); pu.w[2] = pk2(e[4], e[5]); pu.w[3] = pk2(e[6], e[7]); pf[g2][k2] = pu.v; }
                sum += __shfl_xor(sum, 16); sum += __shfl_xor(sum, 32);
                inv[g2] = __builtin_amdgcn_rcpf(sum);
            }
            ATT_SYNC(true); ATT_DMA(rV, 1, 65536);
            const bool more = item + G < NIT; const int nh = (item + G) / RB, nb = ((item + G) % RB) / (SEQ / 256);
            const __amdgpu_buffer_rsrc_t rKn = __builtin_amdgcn_make_buffer_rsrc((void*)(((bf16_t*)(GAS bf16_t*)(wsl + WS_KB)) + (size_t)((more ? nb : b) * NH + (more ? nh : h)) * MEMLEN * HD), (short)0, MEMLEN * HD * 2, 0x00020000);
#pragma unroll
            for (int hv = 0; hv < 2; ++hv) {
                if (hv == 1) { ATT_SYNC(true); if (more) ATT_DMA(rKn, 0, 0); }
#pragma unroll
                for (int g2 = 0; g2 < 2; ++g2) {
#pragma unroll
                    for (int d8 = 0; d8 < 8; ++d8) { f32x4 o = {0.f, 0.f, 0.f, 0.f}; asm volatile("" : "+v"(o));
#pragma unroll
                        for (int k2 = 0; k2 < 8; ++k2) { const bf16x8 vf = ATT_FRAG(hv * 65536, 16 * d8 + fr, 4 * k2 + fq); o = __builtin_amdgcn_mfma_f32_16x16x32_bf16(vf, pf[g2][k2], o, 0, 0, 0); }
                        u32x2 w; w.x = pk2(o[0] * inv[g2], o[1] * inv[g2]); w.y = pk2(o[2] * inv[g2], o[3] * inv[g2]);
                        *(u32x2*)(((bf16_t*)(GAS bf16_t*)(wsl + WS_OB)) + (rowg + 16 * g2) * D + h * HD + 128 * hv + 16 * d8 + 4 * fq) = w; } }
            }
            ATT_SYNC(false); if (more) ATT_DMA(rKn, 1, 65536);
        }
        asm volatile("s_waitcnt vmcnt(0)" ::: "memory");
#undef ATT_DMA
#undef ATT_SYNC
#undef ATT_FRAG
    }
    SEAM(7);

    if (IN(8)) { PHASE_IDS(); pg8::Gemm g{((bf16_t*)(GAS bf16_t*)(wsl + WS_OB)), ((bf16_t*)(GAS bf16_t*)(wsl + WS_WO)), 2 * D}; pg8::StaticOrder S; S.init(M, D, G, bx); pg8::EpiRes<true> E{nullptr, ((bf16_t*)(GAS bf16_t*)(wsl + WS_HB)), ((float*)(GAS float*)(wsl + WS_SS2))};
        pg8::gemm_phase<pg8::EpiRes<true>, pg8::StaticOrder, false, true>(lds, g, S, E, wave); }
    SEAM(8);

    if (IN(9)) { PHASE_IDS();
        LAS float* LG = (LAS float*)(lds + wave * 2112);
        LAS int* HIST = (LAS int*)(lds + 20480); LAS int* BASE = (LAS int*)(lds + 20736);
        for (int blk = bx; blk < M / 128; blk += G) {
            if (tid < NE) HIST[tid] = 0;
            __syncthreads();
            const int m = blk * 128 + wave * 16 + fr;
            f32x4 acc0 = {0.f, 0.f, 0.f, 0.f}, acc1 = {0.f, 0.f, 0.f, 0.f};
            const float rs = rsqrtf(((float*)(GAS float*)(wsl + WS_SS2))[m] * (1.0f / D) + NORM_EPS);
#pragma unroll 16
            for (int ks = 0; ks < 32; ++ks) { const bf16x8 hf = *(const bf16x8*)(((bf16_t*)(GAS bf16_t*)(wsl + WS_HB)) + (size_t)m * D + 32 * ks + 8 * fq);
                { const u32x4 hw = __builtin_bit_cast(u32x4, hf); u32x2 w8; w8.x = pk4_fp8(bflo(hw.x) * rs, bfhi(hw.x) * rs, bflo(hw.y) * rs, bfhi(hw.y) * rs); w8.y = pk4_fp8(bflo(hw.z) * rs, bfhi(hw.z) * rs, bflo(hw.w) * rs, bfhi(hw.w) * rs);
                  *(u32x2*)(((unsigned char*)(wsl + WS_HB8)) + (size_t)m * D + 32 * ks + 8 * fq) = w8; }
                const bf16x8 w0 = *(const bf16x8*)(((bf16_t*)(GAS bf16_t*)(wsl + WS_WRT)) + (size_t)fr * D + 32 * ks + 8 * fq), w1 = *(const bf16x8*)(((bf16_t*)(GAS bf16_t*)(wsl + WS_WRT)) + (size_t)(16 + fr) * D + 32 * ks + 8 * fq);
                acc0 = __builtin_amdgcn_mfma_f32_16x16x32_bf16(w0, hf, acc0, 0, 0, 0); acc1 = __builtin_amdgcn_mfma_f32_16x16x32_bf16(w1, hf, acc1, 0, 0, 0); }
#pragma unroll
            for (int j = 0; j < 4; ++j) { LG[fr * 33 + 4 * fq + j] = acc0[j] * rs + ((const float*)(const GAS float*)(ka[29]))[4 * fq + j]; LG[fr * 33 + 16 + 4 * fq + j] = acc1[j] * rs + ((const float*)(const GAS float*)(ka[29]))[16 + 4 * fq + j]; }
            LDS_WAIT();
            int ek[4] = {0, 0, 0, 0}, pl[4] = {0, 0, 0, 0}; float wk[4] = {0.f, 0.f, 0.f, 0.f};
            if (lane < 16) {
                float v[32];
#pragma unroll
                for (int e = 0; e < 32; ++e) v[e] = LG[lane * 33 + e];
                float tv[4]; unsigned taken = 0u;
#pragma unroll
                for (int k = 0; k < 4; ++k) { float best = 0.f; int bi = -1;
#pragma unroll
                    for (int e = 0; e < 32; ++e) { const bool fre = ((taken >> e) & 1u) == 0u; if (fre && (bi < 0 || v[e] > best)) { best = v[e]; bi = e; } }
                    taken |= 1u << bi; tv[k] = best; ek[k] = bi; }
                float den = 0.f;
#pragma unroll
                for (int k = 0; k < 4; ++k) { wk[k] = __expf(tv[k] - tv[0]); den += wk[k]; }
                const float inv = 1.f / den;
#pragma unroll
                for (int k = 0; k < 4; ++k) { wk[k] *= inv; pl[k] = __hip_atomic_fetch_add(HIST + ek[k], 1, __ATOMIC_RELAXED, __HIP_MEMORY_SCOPE_WORKGROUP); }
            }
            __syncthreads();
            if (tid < NE) { const int hc = HIST[tid]; BASE[tid] = hc ? atomicAdd(((int*)((GAS unsigned*)(wsl + WS_CTL) + CW_CNT)) + tid, hc) : 0; }
            __syncthreads();
            if (lane < 16) {
#pragma unroll
                for (int k = 0; k < 4; ++k) { const int pos = BASE[ek[k]] + pl[k];
                    ((int*)(GAS int*)(wsl + WS_LTOK))[(size_t)ek[k] * ECAP + pos] = m; ((float*)(GAS float*)(wsl + WS_LRS))[(size_t)ek[k] * ECAP + pos] = rs; ((int*)(GAS int*)(wsl + WS_EP))[m * 4 + k] = (ek[k] << 16) | pos; ((float*)(GAS float*)(wsl + WS_WK))[m * 4 + k] = wk[k]; }
            }
            __syncthreads();
        }
    }
    SEAM(9);

    if (IN(11)) { PHASE_IDS(); int tend, cnt, NT; moe_prefix(((int*)((GAS unsigned*)(wsl + WS_CTL) + CW_CNT)), lane, tend, cnt, NT);
        LAS int* mtab = (LAS int*)(lds + 131072); mtab[lane] = tend; mtab[64 + lane] = cnt; LDS_WAIT(); __syncthreads();
        pg8::Gemm g{((unsigned char*)(wsl + WS_HB8)), ((bf16_t*)(GAS bf16_t*)(wsl + WS_WGU)), D}; MoeOrder<3> S{G, vcu, NT, mtab, __builtin_amdgcn_make_buffer_rsrc((void*)((int*)(GAS int*)(wsl + WS_LTOK)), (short)0, NE * ECAP * 4, 0x00020000)}; pg8::EpiSwiglu E{nullptr, (unsigned char*)((bf16_t*)(GAS bf16_t*)(wsl + WS_HMOE)), ((const float*)(const GAS float*)(ka[31])), ((float*)(GAS float*)(wsl + WS_LRS))};
        pg8::gemm_phase<pg8::EpiSwiglu, MoeOrder<3>, true, true, true>(lds, g, S, E, wave); }
    SEAM(11);

    if (IN(12)) { PHASE_IDS(); int tend, cnt, NT; moe_prefix(((int*)((GAS unsigned*)(wsl + WS_CTL) + CW_CNT)), lane, tend, cnt, NT);
        LAS int* mtab = (LAS int*)(lds + 131072); mtab[lane] = tend; mtab[64 + lane] = cnt; LDS_WAIT(); __syncthreads();
        pg8::Gemm g{((bf16_t*)(GAS bf16_t*)(wsl + WS_HMOE)), ((bf16_t*)(GAS bf16_t*)(wsl + WS_WDN)), D}; MoeOrder<2> S{G, vcu, NT, mtab, __builtin_amdgcn_make_buffer_rsrc((void*)((int*)(GAS int*)(wsl + WS_LTOK)), (short)0, NE * ECAP * 4, 0x00020000)}; pg8::EpiBf16<2> E{nullptr, ((bf16_t*)(GAS bf16_t*)(wsl + WS_YSLOT)), D, ((const float*)(const GAS float*)(ka[33])), W8_INV};
        pg8::gemm_phase<pg8::EpiBf16<2>, MoeOrder<2>, false, true, true>(lds, g, S, E, wave); }
    SEAM(12);

    if (IN(13)) { PHASE_IDS(); int tend, cnt, NT; moe_prefix(((int*)((GAS unsigned*)(wsl + WS_CTL) + CW_CNT)), lane, tend, cnt, NT);
        for (int m = gw; m < M; m += NGW) {
            int slot = 0; float w = 0.f;
            { const int k = lane & 3; const int ep = ((int*)(GAS int*)(wsl + WS_EP))[m * 4 + k]; w = ((float*)(GAS float*)(wsl + WS_WK))[m * 4 + k]; const int e = ep >> 16, pos = ep & 0xffff;
              const int tprev = __shfl(tend, (e + 63) & 63); slot = 256 * (e ? tprev : 0) + pos; }
            f32x4 v[4];
#pragma unroll
            for (int j = 0; j < 4; ++j) { const u32x2 hw = *((const u32x2*)(((bf16_t*)(GAS bf16_t*)(wsl + WS_HB)) + (size_t)m * D) + lane + 64 * j); v[j] = (f32x4){bflo(hw.x), bfhi(hw.x), bflo(hw.y), bfhi(hw.y)}; }
#pragma unroll
            for (int k = 0; k < 4; ++k) { int sk = __builtin_amdgcn_readlane(slot, k); sk = sk < 0 ? 0 : (sk >= SLOT_ROWS ? SLOT_ROWS - 1 : sk); const float wk_ = __int_as_float(__builtin_amdgcn_readlane(__float_as_int(w), k));
                const unsigned* yr = (const unsigned*)((const unsigned char*)((bf16_t*)(GAS bf16_t*)(wsl + WS_YSLOT)) + (size_t)sk * D) + lane;
#pragma unroll
                for (int j = 0; j < 4; ++j) { const unsigned y = yr[64 * j]; const f32x2 lo = __builtin_amdgcn_cvt_pk_f32_fp8((int)y, false), hi = __builtin_amdgcn_cvt_pk_f32_fp8((int)y, true);
                    v[j].x += wk_ * lo[0]; v[j].y += wk_ * lo[1]; v[j].z += wk_ * hi[0]; v[j].w += wk_ * hi[1]; } }
            float s = 0.f;
#pragma unroll
            for (int j = 0; j < 4; ++j) s += (v[j].x * v[j].x + v[j].y * v[j].y) + (v[j].z * v[j].z + v[j].w * v[j].w);
            const float rs = rsqrtf(wave_sum(s) * (1.f / D) + NORM_EPS);
#pragma unroll
            for (int j = 0; j < 4; ++j) { const f32x4 gg = *((const f32x4*)((const float*)(const GAS float*)(ka[34])) + lane + 64 * j); *((f32x4*)(OUT + (size_t)m * D) + lane + 64 * j) = v[j] * rs * gg; }
        }
    }
#undef IN
#undef SEAM
}

extern "C" void kernel_launch(void* const* d_in, const int* in_sizes, int n_in, void* d_out, int out_size, void* d_ws, size_t ws_size, hipStream_t stream) {
    static int grid = 0;
    if (grid == 0) {
        if (n_in != 35 || out_size != M * D || ws_size < WS_END) { fprintf(stderr, "kernel_launch: unexpected shapes (n_in %d, out %d, ws %zu); nothing launched\n", n_in, out_size, ws_size); grid = -1; return; }
        int dev = 0, cus = 0, per_cu = 0;
        if (hipGetDevice(&dev) != hipSuccess || hipDeviceGetAttribute(&cus, hipDeviceAttributeMultiprocessorCount, dev) != hipSuccess) { grid = -1; return; }
        if (hipFuncSetAttribute((const void*)hymba_fwd, hipFuncAttributeMaxDynamicSharedMemorySize, LDS_BYTES) != hipSuccess) { fprintf(stderr, "kernel_launch: hipFuncSetAttribute failed\n"); grid = -1; return; }
        if (hipOccupancyMaxActiveBlocksPerMultiprocessor(&per_cu, (const void*)hymba_fwd, NWAVES * 64, LDS_BYTES) != hipSuccess || per_cu < 1) {
            fprintf(stderr, "kernel_launch: occupancy query reports %d workgroups per CU\n", per_cu); (void)hipGetLastError(); grid = -1; return; }
        grid = cus;
    }
    if (grid < 0) return;
    (void)hipMemsetAsync((char*)d_ws + WS_CTL, 0, CTL_ZERO_BYTES, stream);
    Args a{};
    for (int i = 0; i < 35; ++i) a.in[i] = (const float*)d_in[i];
    a.out = (float*)d_out; a.ws = (unsigned char*)d_ws;
    if (MK_N_LAUNCHES == 1) { a.ph_lo = 0; a.ph_hi = N_PHASES; hipLaunchKernelGGL(hymba_fwd, dim3(grid), dim3(NWAVES * 64), LDS_BYTES, stream, a); }
    else { for (int p = 0; p < N_PHASES && p < MK_MAX_PHASE; ++p) { a.ph_lo = p; a.ph_hi = p + 1; hipLaunchKernelGGL(hymba_fwd, dim3(grid), dim3(NWAVES * 64), LDS_BYTES, stream, a); } }
}
```

```cpp
#include <hip/hip_runtime.h>
#include <cstdio>
#include <cstdint>

#ifndef MK_N_LAUNCHES
#define MK_N_LAUNCHES 1
#endif
#ifndef MK_MAX_PHASE
#define MK_MAX_PHASE 14
#endif

#define LAS __attribute__((address_space(3)))
#define GAS __attribute__((address_space(1)))
typedef unsigned short bf16_t;
typedef short bf16x8 __attribute__((ext_vector_type(8)));
typedef float f32x4 __attribute__((ext_vector_type(4)));
typedef float f32x2 __attribute__((ext_vector_type(2)));
typedef unsigned u32x4 __attribute__((ext_vector_type(4)));
typedef unsigned u32x2 __attribute__((ext_vector_type(2)));
typedef int i32x4 __attribute__((ext_vector_type(4)));
typedef int i32x8 __attribute__((ext_vector_type(8)));

constexpr int BATCH = 4, SEQ = 8192, D = 1024, M = BATCH * SEQ;
constexpr int NPROJ = 1536;
constexpr int MEMLEN = 256, NH = 4, HD = 256;
constexpr int NE = 32, ECAP = 32768;
constexpr float NORM_EPS = 1e-6f;
constexpr int RG_TCH = 128, RG_NCH = SEQ / RG_TCH;
constexpr int S5_TCH = 512, S5_NCH = SEQ / S5_TCH;
constexpr int SLOT_ROWS = M * 4 + NE * 256;
constexpr float QSCALE = 0.0625f * 1.44269504088896f;

constexpr size_t MiB = 1u << 20;
constexpr size_t WS_CTL = 0, CTL_ZERO_BYTES = 1 * MiB;
constexpr int CW_BAR = 4096;
constexpr int CW_CNT = 8192, CNT_STRIDE = 1024;
constexpr size_t WS_SS1 = 256 * 1024, WS_SS2 = 384 * 1024;
constexpr int CW_DONE = 163840;
constexpr size_t WS_SMALL = 1 * MiB;
constexpr size_t WS_RGWT = WS_SMALL + 0;
constexpr size_t WS_S5BT = WS_SMALL + 128 * 1024;
constexpr size_t WS_S5CT = WS_SMALL + 384 * 1024;
constexpr size_t WS_S5GT = WS_SMALL + 512 * 1024;
constexpr size_t WS_WRT  = WS_SMALL + 576 * 1024;
constexpr size_t WS_SP8  = WS_SMALL + 640 * 1024;
constexpr size_t WS_S5A  = WS_SMALL + 648 * 1024;
constexpr size_t WS_S5AL = WS_SMALL + 664 * 1024;
constexpr size_t WS_RGP = 2 * MiB, WS_RGH = WS_RGP + 512 * 1024, WS_RGHIN = 3 * MiB, WS_XINV = 3 * MiB + 512 * 1024;
constexpr size_t WS_S5H = 4 * MiB, WS_S5HIN = 5 * MiB;
constexpr size_t WS_KB = 6 * MiB, WS_VT = 8 * MiB;
constexpr size_t WS_MEMB = 10 * MiB;
constexpr size_t WS_WIN = 12 * MiB, WS_WOUT = 15 * MiB, WS_WQ = 17 * MiB, WS_WO = 19 * MiB, WS_WKV = 21 * MiB;
constexpr size_t WS_LTOK = 26 * MiB, WS_LRS = 30 * MiB, WS_EP = 34 * MiB, WS_WK = WS_EP + 512 * 1024;
constexpr size_t WS_WGU = 36 * MiB, WS_WDN = 164 * MiB;
constexpr size_t WS_HB = 228 * MiB;
constexpr size_t WS_HB8 = 100 * MiB;
constexpr float W8_SCALE = 64.f, W8_INV = 1.0f / 64.f;
constexpr size_t WS_XB = 292 * MiB, WS_PROJ = 356 * MiB, WS_YCAT = 452 * MiB, WS_QB = 516 * MiB, WS_OB = 580 * MiB;
constexpr size_t WS_HMOE = 292 * MiB;
constexpr size_t WS_XG8 = 428 * MiB;
constexpr size_t WS_YSLOT = 644 * MiB;
constexpr size_t WS_S5MT = 916 * MiB;
constexpr size_t WS_END = 918 * MiB;

constexpr int RING_BYTES = 150016;
constexpr int MISC_OFF = RING_BYTES + 64;
constexpr int BIAS_OFF = 131072 + 512;
constexpr int GTAB_OFF = 131072 + 512 + 2048;
constexpr int LDS_BYTES = 158208;

typedef __bf16 bf16x2v __attribute__((ext_vector_type(2)));
__device__ __forceinline__ unsigned pk2(float lo, float hi) { const f32x2 v = {lo, hi}; const bf16x2v b = __builtin_convertvector(v, bf16x2v); return __builtin_bit_cast(unsigned, b); }
__device__ __forceinline__ unsigned cvt_pk_bf16(float lo, float hi) { return pk2(lo, hi); }
__device__ __forceinline__ unsigned pk4_fp8(float a, float b, float c, float d) { int w = __builtin_amdgcn_cvt_pk_fp8_f32(a, b, 0, false); w = __builtin_amdgcn_cvt_pk_fp8_f32(c, d, w, true); return (unsigned)w; }
__device__ __forceinline__ bf16_t f2bf(float x) { return (bf16_t)(pk2(x, 0.f) & 0xffffu); }
__device__ __forceinline__ float bf2f(bf16_t x) { return __uint_as_float((unsigned)x << 16); }
__device__ __forceinline__ float bflo(unsigned w) { return __uint_as_float(w << 16); }
__device__ __forceinline__ float bfhi(unsigned w) { return __uint_as_float(w & 0xffff0000u); }
__device__ __forceinline__ float sigmoidf_(float x) { return __builtin_amdgcn_rcpf(1.f + __expf(-x)); }
__device__ __forceinline__ float gelu_tanh(float x) { const float p = fmaf(x * x, -1.44269504f * 1.5957691216057308f * 0.044715f, -1.44269504f * 1.5957691216057308f); return x * __builtin_amdgcn_rcpf(1.f + __builtin_amdgcn_exp2f(x * p)); }
__device__ __forceinline__ float wave_sum(float v) {
#pragma unroll
    for (int o = 1; o < 64; o <<= 1) v += __shfl_xor(v, o);
    return v;
}
__device__ __forceinline__ int lane_id() { return (int)__builtin_amdgcn_mbcnt_hi(~0u, __builtin_amdgcn_mbcnt_lo(~0u, 0u)); }
#define LDS_WAIT() asm volatile("s_waitcnt lgkmcnt(0)" ::: "memory")
#define VM_WAIT() asm volatile("s_waitcnt vmcnt(0)" ::: "memory")

namespace pg8 {
#define PG8_LAS __attribute__((address_space(3)))
constexpr int BM = 256, BK = 64, HALF = 128, HTB = HALF * BK * 2, STAGE_BYTES = 8 * HTB, NXCD = 8, WGM = 8;
__host__ __device__ __forceinline__ int lds_byte(int r, int c) { const int st = (r >> 4) * 2 + (c >> 5), rr = r & 15, cc = c & 31, ob = rr * 64 + cc * 2; return st * 1024 + (ob ^ (((ob >> 9) & 1) << 5)); }
__host__ __device__ __forceinline__ void stage_rc(int b, int& R, int& C) { const int st = b / 1024, sb = b % 1024, swz = sb ^ (((sb >> 9) & 1) << 5); R = (st >> 1) * 16 + swz / 64; C = (st & 1) * 32 + (swz % 64) / 2; }
__host__ __device__ __forceinline__ int perm32(int rho) { const int n = rho >> 4, i = rho & 15; return 8 * (i >> 2) + 4 * n + (i & 3); }

struct Unit { int pm, pn, pb, e, r0, ne; };
struct Gemm { const void* A; const void* Bt; int KB; };

struct StaticOrder {
    int nM, nN, nwg, G, c;
    __device__ void init(int M_, int N_, int G_, int c_) { nM = M_ / BM; nN = N_ / BM; nwg = nM * nN; G = G_; c = c_; }
    __device__ bool next(int i, Unit& u) const {
        const long L = (long)i * G + c; if (L >= nwg) return false;
        int wgid = (int)L; { const int q = nwg / NXCD, r = nwg % NXCD, xcd = wgid % NXCD, off = wgid / NXCD; wgid = (xcd < r ? xcd * (q + 1) : r * (q + 1) + (xcd - r) * q) + off; }
        const int nig = WGM * nN, gid = wgid / nig, fm = gid * WGM, gsz = (nM - fm) < WGM ? (nM - fm) : WGM;
        u.pm = fm + ((wgid % nig) % gsz); u.pn = (wgid % nig) / gsz; u.pb = u.pn; u.e = 0; u.r0 = 0; u.ne = 0; return true;
    }
    __device__ __forceinline__ int row_tok(const Unit&, int) const { return 0; }
    __device__ __forceinline__ void unit_done(int) const {}
    static constexpr bool SIGNAL = false;
};

template <class Epi, class Sched, bool GATHER, bool ALIGN_EPI, bool FP8 = false>
__device__ __forceinline__ void gemm_phase(PG8_LAS unsigned char* lds, const Gemm g, const Sched& S, Epi E, const int wid) {
    int tid = wid * 64 + lane_id(); asm volatile("" : "+v"(tid));
    const int lane = tid & 63, wr = wid >> 2, wc = wid & 3, fr = lane & 15, fq = lane >> 4;
    const int KB = g.KB, nt = KB / (BK * 2);
    unsigned voffA[2], voffB[2];
#pragma unroll
    for (int i = 0; i < 2; ++i) { int R, C; stage_rc(tid * 16 + i * 8192, R, C); const int Rb = Epi::PERM == 2 ? (64 * (R >> 5) + 16 * ((R >> 2) & 3) + 4 * ((R >> 4) & 1) + (R & 3)) : Epi::PERM ? ((R & ~31) + perm32(R & 31)) : R;
        voffA[i] = (unsigned)(R * KB + C * 2); voffB[i] = (unsigned)(Rb * KB + C * 2); }
    const unsigned kstep = (unsigned)(BK * 2);
    const unsigned hstep = (unsigned)HALF * (unsigned)KB;
    const unsigned tstep = 2u * hstep;
    const unsigned hstepB = Epi::PERM == 2 ? 8u * (unsigned)KB : hstep;
    const __amdgpu_buffer_rsrc_t rA = __builtin_amdgcn_make_buffer_rsrc((void*)g.A, (short)0, 0x7fffffff, 0x00020000);
    const __amdgpu_buffer_rsrc_t rB = __builtin_amdgcn_make_buffer_rsrc((void*)g.Bt, (short)0, 0x7fffffff, 0x00020000);
    const unsigned ldsw = (unsigned)wid * 1024u;
    const int aoff = lds_byte(wr * 64 + fr, fq * 8), boff = lds_byte(wc * 32 + fr, fq * 8);
    PG8_LAS unsigned* gslot = (PG8_LAS unsigned*)(lds + GTAB_OFF) + tid * 4;
    PG8_LAS unsigned* nslot = gslot + 2048;
    unsigned ntk[4] = {0u, 0u, 0u, 0u};
#define PG8_SA(b, h) (((b) * 2 + (h)) * HTB)
#define PG8_SB(b, h) ((4 + (b) * 2 + (h)) * HTB)
#define PG8_STAGE_B(bufoff, soff) do { _Pragma("unroll") for (int _i = 0; _i < 2; ++_i) \
        __builtin_amdgcn_raw_ptr_buffer_load_lds(rB, (PG8_LAS unsigned*)(lds + (bufoff) + ldsw + _i * 8192), 16, voffB[_i], (soff), 0, 0); } while (0)
#define PG8_STAGE_A(bufoff, nx, kb, h) do { _Pragma("unroll") for (int _i = 0; _i < 2; ++_i) { \
        if constexpr (GATHER) __builtin_amdgcn_raw_ptr_buffer_load_lds(rA, (PG8_LAS unsigned*)(lds + (bufoff) + ldsw + _i * 8192), 16, gslot[(h) * 2 + _i], (kb), 0, 0); \
        else __builtin_amdgcn_raw_ptr_buffer_load_lds(rA, (PG8_LAS unsigned*)(lds + (bufoff) + ldsw + _i * 8192), 16, voffA[_i], ((nx) ? nA : cA) + (kb) + (unsigned)(h) * hstep, 0, 0); } } while (0)
#define PG8_LDA(dst, b, h) do { _Pragma("unroll") for (int m = 0; m < 4; ++m) _Pragma("unroll") for (int k = 0; k < 2; ++k) dst[m][k] = *(const PG8_LAS bf16x8*)(lds + PG8_SA(b, h) + aoff + m * 2048 + k * 1024); } while (0)
#define PG8_LDB(dst, b, h) do { _Pragma("unroll") for (int n = 0; n < 2; ++n) _Pragma("unroll") for (int k = 0; k < 2; ++k) dst[n][k] = *(const PG8_LAS bf16x8*)(lds + PG8_SB(b, h) + boff + n * 2048 + k * 1024); } while (0)
#define PG8_CAT(x) __builtin_shufflevector(__builtin_bit_cast(i32x4, x[0]), __builtin_bit_cast(i32x4, x[1]), 0, 1, 2, 3, 4, 5, 6, 7)
#define PG8_MMA(ai, bj, At, Bt) do { __builtin_amdgcn_s_setprio(1); \
        if constexpr (FP8) { _Pragma("unroll") for (int m = 0; m < 4; ++m) _Pragma("unroll") for (int n = 0; n < 2; ++n) \
            acc[ai][bj][m][n] = __builtin_amdgcn_mfma_scale_f32_16x16x128_f8f6f4(PG8_CAT(Bt[n]), PG8_CAT(At[m]), acc[ai][bj][m][n], 0, 0, 0, 0, 0, 0); } \
        else { _Pragma("unroll") for (int m = 0; m < 4; ++m) _Pragma("unroll") for (int n = 0; n < 2; ++n) _Pragma("unroll") for (int k = 0; k < 2; ++k) \
            acc[ai][bj][m][n] = __builtin_amdgcn_mfma_f32_16x16x32_bf16(Bt[n][k], At[m][k], acc[ai][bj][m][n], 0, 0, 0); } \
        __builtin_amdgcn_s_setprio(0); } while (0)
#define PG8_WAIT_V(n) asm volatile("s_waitcnt vmcnt(" #n ")" ::: "memory")
#define PG8_WAIT_L(n) asm volatile("s_waitcnt lgkmcnt(" #n ")" ::: "memory")
#define PG8_BAR __builtin_amdgcn_s_barrier()
#define PG8_SCHED __builtin_amdgcn_sched_barrier(0)
#define PG8_GROW(h_, u) do { if constexpr (GATHER) { _Pragma("unroll") for (int _i = 0; _i < 2; ++_i) { int _R, _C; stage_rc(tid * 16 + _i * 8192, _R, _C); \
        gslot[(h_) * 2 + _i] = (unsigned)S.row_tok(u, _R + (h_) * HALF) * (unsigned)KB + (unsigned)(_C * 2); } } } while (0)
    Unit cur, nxt; int ui = 0; int prev_pm = 0; (void)prev_pm;
    if (!S.next(0, cur)) return;
    f32x4 acc[2][2][4][2];
#pragma unroll
    for (int a = 0; a < 2; ++a)
#pragma unroll
        for (int b = 0; b < 2; ++b)
#pragma unroll
            for (int m = 0; m < 4; ++m)
#pragma unroll
                for (int n = 0; n < 2; ++n) acc[a][b][m][n] = (f32x4){0.f, 0.f, 0.f, 0.f};
    bf16x8 At[4][2], B0[2][2], B1[2][2];
    unsigned cA = (unsigned)cur.pm * tstep, cB = (unsigned)cur.pb * tstep;
    unsigned nA = cA;
    PG8_GROW(0, cur); PG8_GROW(1, cur);
    if constexpr (Epi::ACCINIT) { if (wid == 0) E.prefetch(cur, (PG8_LAS unsigned*)(lds + BIAS_OFF), lane); PG8_WAIT_V(0); PG8_BAR; E.acc_init(acc, (const PG8_LAS float*)(lds + BIAS_OFF), wc, fq); }
    PG8_STAGE_B(PG8_SB(0, 0), cB); PG8_STAGE_B(PG8_SB(0, 1), cB + hstepB); PG8_STAGE_A(PG8_SA(0, 0), false, 0, 0); PG8_STAGE_A(PG8_SA(0, 1), false, 0, 1);
    if (wr == 1) PG8_BAR;
    PG8_WAIT_V(2); PG8_BAR;
    PG8_STAGE_B(PG8_SB(1, 0), cB + kstep); PG8_STAGE_A(PG8_SA(1, 0), false, kstep, 0); PG8_STAGE_B(PG8_SB(1, 1), cB + hstepB + kstep);
    PG8_WAIT_V(6); PG8_BAR;
    for (;;) {
        const bool has_next = S.next(ui + 1, nxt);
        if constexpr (Epi::ACCINIT) { if (wid == 0 && has_next) E.prefetch(nxt, (PG8_LAS unsigned*)(lds + BIAS_OFF + ((ui + 1) & 1) * 1024), lane); }
        else if constexpr (Epi::LDSBIAS) { if (wid == 0) E.prefetch(cur, (PG8_LAS unsigned*)(lds + BIAS_OFF + (ui & 1) * 1024), lane); }
        if constexpr (GATHER) { if (has_next) {
#pragma unroll
            for (int _h = 0; _h < 2; ++_h)
#pragma unroll
                for (int _i = 0; _i < 2; ++_i) { int _R, _C; stage_rc(tid * 16 + _i * 8192, _R, _C); ntk[_h * 2 + _i] = (unsigned)S.row_tok(nxt, _R + _h * HALF) * (unsigned)KB + (unsigned)(_C * 2); } } }
        nA = has_next ? (unsigned)nxt.pm * tstep : cA; const unsigned nB = has_next ? (unsigned)nxt.pb * tstep : cB;
#pragma nounroll
        for (int t = 0; t < nt; t += 2) {
            const bool last = (t == nt - 2);
            const unsigned kb1 = (unsigned)(t + 1) * kstep;
            const unsigned kb2 = last ? 0u : (unsigned)(t + 2) * kstep; const unsigned b2 = last ? nB : cB + (unsigned)(t + 2) * kstep;
            const unsigned kb3 = kb2 + kstep; const unsigned b3 = b2 + kstep;
            if constexpr (GATHER) { if (has_next && (t == 2 || nt == 2)) { nslot[0] = ntk[0]; nslot[1] = ntk[1]; nslot[2] = ntk[2]; nslot[3] = ntk[3]; }
                if (last && has_next) { gslot[0] = nslot[0]; gslot[1] = nslot[1]; } }
            PG8_LDB(B0, 0, 0); PG8_LDB(B1, 0, 1); PG8_SCHED; PG8_LDA(At, 0, 0); PG8_STAGE_A(PG8_SA(1, 1), false, kb1, 1);
            if constexpr (GATHER) { if (last && has_next) { gslot[2] = nslot[2]; gslot[3] = nslot[3]; } }
            PG8_WAIT_V(8); PG8_WAIT_L(0); PG8_BAR; PG8_MMA(0, 0, At, B0); PG8_MMA(0, 1, At, B1); PG8_BAR; PG8_SCHED;
            PG8_LDA(At, 0, 1); PG8_STAGE_B(PG8_SB(0, 0), b2); PG8_STAGE_B(PG8_SB(0, 1), b2 + hstepB); PG8_STAGE_A(PG8_SA(0, 0), last, kb2, 0);
            PG8_WAIT_V(8); PG8_WAIT_L(0);
            if constexpr (Sched::SIGNAL) { if (t == 0 && ui > 0) S.unit_done(prev_pm); }
            PG8_BAR; PG8_MMA(1, 0, At, B0); PG8_MMA(1, 1, At, B1); PG8_BAR; PG8_SCHED;
            PG8_LDB(B0, 1, 0); PG8_LDB(B1, 1, 1); PG8_SCHED; PG8_LDA(At, 1, 0); PG8_STAGE_A(PG8_SA(0, 1), last, kb2, 1);
            PG8_WAIT_V(8); PG8_WAIT_L(0); PG8_BAR; PG8_MMA(0, 0, At, B0); PG8_MMA(0, 1, At, B1); PG8_BAR; PG8_SCHED;
            PG8_LDA(At, 1, 1); PG8_STAGE_B(PG8_SB(1, 0), b3); PG8_STAGE_B(PG8_SB(1, 1), b3 + hstepB); PG8_STAGE_A(PG8_SA(1, 0), last, kb3, 0);
            PG8_WAIT_V(8); PG8_WAIT_L(0); PG8_BAR; PG8_MMA(1, 0, At, B0); PG8_MMA(1, 1, At, B1); PG8_BAR; PG8_SCHED;
        }
        if constexpr (ALIGN_EPI) { if (wr == 0) PG8_BAR; }
        { int et = lane_id(); asm volatile("" : "+v"(et)); if constexpr (Epi::LDSBIAS) E.slot = (const PG8_LAS float*)(lds + BIAS_OFF + (ui & 1) * 1024); E(acc, cur, wr, wc, et & 15, et >> 4); }
        if (!has_next) break;
        if constexpr (Epi::ACCINIT) E.acc_init(acc, (const PG8_LAS float*)(lds + BIAS_OFF + ((ui + 1) & 1) * 1024), wc, fq);
        else { float zv = 0.f; asm volatile("" : "+v"(zv));
#pragma unroll
          for (int a = 0; a < 2; ++a)
#pragma unroll
            for (int b = 0; b < 2; ++b)
#pragma unroll
                for (int m = 0; m < 4; ++m)
#pragma unroll
                    for (int n = 0; n < 2; ++n) { asm volatile("" : "+v"(zv)); acc[a][b][m][n] = __builtin_amdgcn_mfma_f32_4x4x1f32(zv, zv, (f32x4){0.f, 0.f, 0.f, 0.f}, 0, 0, 0); } }
        prev_pm = cur.pm; cur = nxt; cA = nA; cB = nB; ++ui;
        if constexpr (ALIGN_EPI) { if (wr == 1) PG8_BAR; }
    }
    PG8_WAIT_V(0);
    if constexpr (Sched::SIGNAL) S.unit_done(cur.pm);
    if constexpr (!ALIGN_EPI) { if (wr == 0) PG8_BAR; }
    PG8_BAR;
#undef PG8_SA
#undef PG8_SB
#undef PG8_STAGE_A
#undef PG8_STAGE_B
#undef PG8_LDA
#undef PG8_LDB
#undef PG8_MMA
#undef PG8_CAT
#undef PG8_WAIT_V
#undef PG8_WAIT_L
#undef PG8_BAR
#undef PG8_SCHED
#undef PG8_GROW
}

template <int MODE> struct EpiBf16 {
    static constexpr int PERM = 2; static constexpr bool LDSBIAS = (MODE == 2), ACCINIT = false; const PG8_LAS float* slot;
    bf16_t* O; int ldc; const float* aux; float cst;
    __device__ __forceinline__ void prefetch(const Unit& u, PG8_LAS unsigned* dst, int lane) const {
        const __amdgpu_buffer_rsrc_t r = __builtin_amdgcn_make_buffer_rsrc((void*)aux, (short)0, NE * 1024 * 4, 0x00020000);
        __builtin_amdgcn_raw_ptr_buffer_load_lds(r, dst, 16, (unsigned)lane * 16u, (unsigned)(u.e * 1024 + u.pn * BM) * 4u, 0, 0); }
    __device__ __forceinline__ void operator()(const f32x4 (&acc)[2][2][4][2], const Unit& u, int wr, int wc, int fr, int fq) const {
        const int row0 = u.pm * BM + wr * 64 + fr, col0 = u.pn * BM + wc * 64 + 16 * fq;
        if constexpr (MODE == 2) {
            f32x4 bv[2][2];
#pragma unroll
            for (int bj = 0; bj < 2; ++bj)
#pragma unroll
                for (int n = 0; n < 2; ++n) bv[bj][n] = *(const PG8_LAS f32x4*)(slot + wc * 64 + 16 * fq + 8 * bj + 4 * n);
#pragma unroll
            for (int ai = 0; ai < 2; ++ai)
#pragma unroll
                for (int m = 0; m < 4; ++m) { u32x4 o;
                    { const f32x4 v0 = acc[ai][0][m][0] * cst + bv[0][0], v1 = acc[ai][0][m][1] * cst + bv[0][1]; o.x = pk4_fp8(v0[0], v0[1], v0[2], v0[3]); o.y = pk4_fp8(v1[0], v1[1], v1[2], v1[3]); }
                    { const f32x4 v0 = acc[ai][1][m][0] * cst + bv[1][0], v1 = acc[ai][1][m][1] * cst + bv[1][1]; o.z = pk4_fp8(v0[0], v0[1], v0[2], v0[3]); o.w = pk4_fp8(v1[0], v1[1], v1[2], v1[3]); }
                    *(u32x4*)((unsigned char*)O + (size_t)(row0 + ai * HALF + m * 16) * ldc + u.pn * BM + wc * 64 + 16 * fq) = o; }
            return; }
#pragma unroll
        for (int ai = 0; ai < 2; ++ai)
#pragma unroll
            for (int m = 0; m < 4; ++m) { const int row = row0 + ai * HALF + m * 16; bf16_t* rowp = O + (size_t)row * ldc + col0;
                float sc = 1.f; if (MODE == 1) sc = rsqrtf(aux[row] * (1.0f / D) + NORM_EPS) * cst;
#pragma unroll
                for (int bj = 0; bj < 2; ++bj) { const f32x4 v0 = acc[ai][bj][m][0] * sc, v1 = acc[ai][bj][m][1] * sc;
                    u32x4 w; w.x = cvt_pk_bf16(v0[0], v0[1]); w.y = cvt_pk_bf16(v0[2], v0[3]); w.z = cvt_pk_bf16(v1[0], v1[1]); w.w = cvt_pk_bf16(v1[2], v1[3]);
                    *(u32x4*)(rowp + bj * 8) = w; } }
    }
};
struct EpiKV {
    static constexpr bool PERM = false, LDSBIAS = false, ACCINIT = false;
    bf16_t* KB; bf16_t* VT;
    __device__ __forceinline__ void operator()(const f32x4 (&acc)[2][2][4][2], const Unit& u, int wr, int wc, int fr, int fq) const {
        const int b = u.pm, isv = u.pn >> 2, h = u.pn & 3;
#pragma unroll
        for (int ai = 0; ai < 2; ++ai)
#pragma unroll
            for (int m = 0; m < 4; ++m) { const int mem = ai * HALF + wr * 64 + m * 16 + fr;
                const int pmem = (mem & ~31) + 8 * ((mem >> 2) & 3) + 4 * ((mem >> 4) & 1) + (mem & 3);
#pragma unroll
                for (int bj = 0; bj < 2; ++bj)
#pragma unroll
                    for (int n = 0; n < 2; ++n) { const int d0 = bj * HALF + wc * 32 + n * 16 + 4 * fq; const f32x4 v = acc[ai][bj][m][n];
                        if (!isv) { u32x2 w; w.x = cvt_pk_bf16(v[0], v[1]); w.y = cvt_pk_bf16(v[2], v[3]); *(u32x2*)(KB + ((size_t)((b * NH + h) * MEMLEN + mem)) * HD + d0) = w; }
                        else {
#pragma unroll
                            for (int j = 0; j < 4; ++j) VT[((size_t)((b * NH + h) * HD + d0 + j)) * MEMLEN + pmem] = f2bf(v[j]); } } }
    }
};
template <bool BF16BASE> struct EpiRes {
    static constexpr int PERM = 2; static constexpr bool LDSBIAS = false, ACCINIT = false;
    const float* base; bf16_t* hb; float* ss; const bf16_t* xb;
    __device__ __forceinline__ void operator()(const f32x4 (&acc)[2][2][4][2], const Unit& u, int wr, int wc, int fr, int fq) const {
        const int row0 = u.pm * BM + wr * 64 + fr, col0 = u.pn * BM + wc * 64 + 16 * fq;
#pragma unroll
        for (int ai = 0; ai < 2; ++ai)
#pragma unroll
            for (int m = 0; m < 4; ++m) { const int row = row0 + ai * HALF + m * 16; const size_t off = (size_t)row * D + col0; float s = 0.f; float xi = 1.f; if (!BF16BASE) xi = base[row];
#pragma unroll
                for (int bj = 0; bj < 2; ++bj) { f32x4 b0, b1;
                    if (BF16BASE) { const u32x4 bw = *(const u32x4*)(hb + off + bj * 8); b0 = (f32x4){bflo(bw.x), bfhi(bw.x), bflo(bw.y), bfhi(bw.y)}; b1 = (f32x4){bflo(bw.z), bfhi(bw.z), bflo(bw.w), bfhi(bw.w)}; }
                    else { const u32x4 bw = *(const u32x4*)(xb + off + bj * 8); b0 = (f32x4){bflo(bw.x), bfhi(bw.x), bflo(bw.y), bfhi(bw.y)} * xi; b1 = (f32x4){bflo(bw.z), bfhi(bw.z), bflo(bw.w), bfhi(bw.w)} * xi; }
                    const f32x4 v0 = b0 + acc[ai][bj][m][0], v1 = b1 + acc[ai][bj][m][1];
                    u32x4 w; w.x = cvt_pk_bf16(v0[0], v0[1]); w.y = cvt_pk_bf16(v0[2], v0[3]); w.z = cvt_pk_bf16(v1[0], v1[1]); w.w = cvt_pk_bf16(v1[2], v1[3]);
                    *(u32x4*)(hb + off + bj * 8) = w;
                    s += (v0[0] * v0[0] + v0[1] * v0[1]) + (v0[2] * v0[2] + v0[3] * v0[3]) + (v1[0] * v1[0] + v1[1] * v1[1]) + (v1[2] * v1[2] + v1[3] * v1[3]); }
                s += __shfl_xor(s, 16); s += __shfl_xor(s, 32);
                if (fq == 0) unsafeAtomicAdd(ss + row, s);
                asm volatile("" ::: "memory"); }
    }
};
struct EpiSwiglu {
    static constexpr bool PERM = true, LDSBIAS = true, ACCINIT = true; const PG8_LAS float* slot;
    unsigned char* H; const float* bgu; const float* lrs;
    __device__ __forceinline__ void prefetch(const Unit& u, PG8_LAS unsigned* dst, int lane) const {
        const __amdgpu_buffer_rsrc_t r = __builtin_amdgcn_make_buffer_rsrc((void*)bgu, (short)0, NE * 2048 * 4, 0x00020000);
        __builtin_amdgcn_raw_ptr_buffer_load_lds(r, dst, 16, (unsigned)((lane & 31) * 16 + (lane >> 5) * 4096), (unsigned)(u.e * 2048 + u.pn * HALF) * 4u, 0, 0); }
    __device__ __forceinline__ void acc_init(f32x4 (&acc)[2][2][4][2], const PG8_LAS float* sl, int wc, int fq) const {
        f32x4 bg[2], bu[2];
#pragma unroll
        for (int n = 0; n < 2; ++n) { bg[n] = *(const PG8_LAS f32x4*)(sl + wc * 32 + 8 * fq + 4 * n) * W8_SCALE; bu[n] = (*(const PG8_LAS f32x4*)(sl + 128 + wc * 32 + 8 * fq + 4 * n) + 1.0f) * W8_SCALE; }
        float zv = 0.f;
#pragma unroll
        for (int ai = 0; ai < 2; ++ai)
#pragma unroll
            for (int m = 0; m < 4; ++m)
#pragma unroll
                for (int n = 0; n < 2; ++n) { asm volatile("" : "+v"(zv)); acc[ai][0][m][n] = __builtin_amdgcn_mfma_f32_4x4x1f32(zv, zv, bg[n], 0, 0, 0);
                    asm volatile("" : "+v"(zv)); acc[ai][1][m][n] = __builtin_amdgcn_mfma_f32_4x4x1f32(zv, zv, bu[n], 0, 0, 0); }
    }
    __device__ __forceinline__ void operator()(const f32x4 (&acc)[2][2][4][2], const Unit& u, int wr, int wc, int fr, int fq) const {
        const int hc0 = u.pn * HALF + wc * 32 + 8 * fq;
        const bool odd = (fq & 1) != 0;
#pragma unroll
        for (int ai = 0; ai < 2; ++ai)
#pragma unroll
            for (int m0 = 0; m0 < 4; m0 += 2) { u32x2 w8[2];
#pragma unroll
                for (int mm = 0; mm < 2; ++mm) { const int m = m0 + mm; float hv[8];
#pragma unroll
                    for (int n = 0; n < 2; ++n) { const f32x4 gv = acc[ai][0][m][n], uv = acc[ai][1][m][n];
#pragma unroll
                        for (int j = 0; j < 4; j += 2) {
                            f32x2 g2, u2; g2.x = fminf(gv[j], 7.0f * W8_SCALE); g2.y = fminf(gv[j + 1], 7.0f * W8_SCALE); u2.x = __builtin_amdgcn_fmed3f(uv[j], -6.0f * W8_SCALE, 8.0f * W8_SCALE); u2.y = __builtin_amdgcn_fmed3f(uv[j + 1], -6.0f * W8_SCALE, 8.0f * W8_SCALE);
                            const f32x2 t2 = g2 * (-1.702f * 1.44269504f * W8_INV); f32x2 e2; e2.x = __builtin_amdgcn_exp2f(t2.x); e2.y = __builtin_amdgcn_exp2f(t2.y);
                            const f32x2 d2 = e2 * (W8_SCALE * W8_SCALE) + (W8_SCALE * W8_SCALE); f32x2 r2; r2.x = __builtin_amdgcn_rcpf(d2.x); r2.y = __builtin_amdgcn_rcpf(d2.y);
                            const f32x2 h2 = (u2 * g2) * r2; hv[4 * n + j] = h2.x; hv[4 * n + j + 1] = h2.y; } }
                    w8[mm].x = pk4_fp8(hv[0], hv[1], hv[2], hv[3]); w8[mm].y = pk4_fp8(hv[4], hv[5], hv[6], hv[7]); }
                const auto px = __builtin_amdgcn_permlane16_swap(w8[0].x, w8[1].x, false, false), py = __builtin_amdgcn_permlane16_swap(w8[0].y, w8[1].y, false, false);
                u32x4 o; o.x = px[0]; o.y = py[0]; o.z = px[1]; o.w = py[1];
                const int rl = ai * HALF + wr * 64 + (m0 + (odd ? 1 : 0)) * 16 + fr;
                *(u32x4*)(H + (size_t)(u.pm * BM + rl) * D + hc0 - (odd ? 8 : 0)) = o; }
    }
};
}

__device__ __forceinline__ void moe_prefix(const int* counts, int lane, int& tend, int& cnt, int& NT) {
    cnt = lane < NE ? counts[lane * CNT_STRIDE] : 0;
    int t = (cnt + 255) >> 8;
#pragma unroll
    for (int o = 1; o < 32; o <<= 1) { const int v = __shfl_up(t, o); if ((lane & 31) >= o) t += v; }
    NT = __builtin_amdgcn_readlane(t, 31);
    tend = lane < NE ? t : 0x7fffffff;
}
template <int NCSHIFT> struct MoeOrder {
    static constexpr bool SIGNAL = (NCSHIFT == 3);
    int G, vc, nlim, rt0; const LAS int* tab; __amdgpu_buffer_rsrc_t rl; GAS unsigned* done;
    __device__ __forceinline__ bool next(int i, pg8::Unit& u) const {
        const int L = i * G + vc; if (L >= nlim) return false;
        const int rt = rt0 + (L >> NCSHIFT), cb = L & ((1 << NCSHIFT) - 1);
        const int lane_ = lane_id(); const int tend = tab[lane_], cnt = tab[64 + lane_];
        const unsigned long long mask = __ballot(tend <= rt);
        const int e = __builtin_amdgcn_readfirstlane(__popcll(mask));
        const int ts = e ? __builtin_amdgcn_readlane(tend, e - 1) : 0;
        u.pm = rt; u.pn = cb; u.pb = (e << NCSHIFT) + cb; u.e = e; u.r0 = (rt - ts) * 256; u.ne = __builtin_amdgcn_readlane(cnt, e);
        if constexpr (NCSHIFT == 2) { unsigned sp = 0u; while (__hip_atomic_load(done + rt, __ATOMIC_RELAXED, __HIP_MEMORY_SCOPE_AGENT) < 64u) { __builtin_amdgcn_s_sleep(1); if (++sp > (1u << 22)) break; } asm volatile("" ::: "memory"); }
        return true;
    }
    __device__ __forceinline__ void unit_done(int pm) const { if constexpr (NCSHIFT == 3) { if (lane_id() == 0) (void)__hip_atomic_fetch_add(done + pm, 1u, __ATOMIC_RELAXED, __HIP_MEMORY_SCOPE_AGENT); } }
    __device__ __forceinline__ int row_tok(const pg8::Unit& u, int R) const { const int pos = u.r0 + R; const int pc = pos < ECAP ? pos : ECAP - 1;
        const int t = __builtin_amdgcn_raw_buffer_load_b32(rl, (u.e * ECAP + pc) * 4, 0, 0); return pos < u.ne ? t : 0; }
};

#define XB_TMO      128
#define XB_XCNT(j)  (256  + 64 * (j))
#define XB_XSUB(j)  (1280 + 64 * (j))
#define XB_XGEN(j)  (2304 + 64 * (j))
#define XB_TOP      3328
#define XB_TOPGEN   3392
#define XCD_BAR_WORDS 3456
#define XB_SPIN_CAP (1u << 22)
__device__ __forceinline__ unsigned xb_ld(unsigned* p)              { return __hip_atomic_load(p, __ATOMIC_RELAXED, __HIP_MEMORY_SCOPE_AGENT); }
__device__ __forceinline__ unsigned xb_add(unsigned* p, unsigned v) { return __hip_atomic_fetch_add(p, v, __ATOMIC_RELAXED, __HIP_MEMORY_SCOPE_AGENT); }
__device__ __forceinline__ unsigned xb_xcc_id() { return (unsigned)__builtin_amdgcn_s_getreg((3 << 11) | 20) & 0xFu; }
#define XB_SPIN(cond, bar) do { unsigned _sp = 0; while (cond) { __builtin_amdgcn_s_sleep(1); \
    if ((++_sp & 255u) == 0u) { if (xb_ld(&(bar)[XB_TMO])) break; if (_sp > XB_SPIN_CAP) { atomicAdd(&(bar)[XB_TMO], 1u); break; } } } } while (0)
struct XcdBarrier { unsigned* bar; unsigned x; volatile LAS unsigned* st; unsigned rank; };
__device__ __forceinline__ XcdBarrier xcd_barrier_post(unsigned* bar, volatile LAS unsigned* st, bool leader) {
    XcdBarrier b; b.bar = bar; b.x = xb_xcc_id(); b.st = st;
    b.rank = 0u; if (leader) b.rank = xb_add(&bar[XB_XCNT(b.x)], 1u);
    return b;
}
__device__ __forceinline__ void xcd_barrier_complete(unsigned* bar, unsigned x, unsigned& nloc, unsigned& nx) {
    const unsigned G = gridDim.x * gridDim.y * gridDim.z;
    unsigned sum, cnt, mine, sp = 0u;
    for (;;) {
        sum = 0u; cnt = 0u; mine = 0u;
#pragma unroll
        for (unsigned j = 0; j < 16; ++j) { const unsigned c = xb_ld(&bar[XB_XCNT(j)]); sum += c; cnt += (c > 0u) ? 1u : 0u; mine = (j == x) ? c : mine; }
        if (sum == G) break;
        __builtin_amdgcn_s_sleep(1);
        if ((++sp & 255u) == 0u) { if (xb_ld(&bar[XB_TMO])) break; if (sp > XB_SPIN_CAP) { atomicAdd(&bar[XB_TMO], 1u); break; } }
    }
    nloc = mine > 0u ? mine : 1u; nx = cnt > 0u ? cnt : 1u;
}
__device__ __forceinline__ void xcd_barrier(const XcdBarrier& b, bool leader) {
    asm volatile("s_waitcnt vmcnt(0)" ::: "memory");
    __syncthreads();
    if (leader) {
        unsigned* bar = b.bar;
        __builtin_amdgcn_s_waitcnt(0);
        unsigned nloc = b.st[0], nx = b.st[1];
        if (nloc == 0u) { xcd_barrier_complete(bar, b.x, nloc, nx); b.st[0] = nloc; b.st[1] = nx; }
        const unsigned old = xb_add(&bar[XB_XSUB(b.x)], 1u);
        const unsigned gen = old / nloc;
        if (old + 1u == (gen + 1u) * nloc) {
            __builtin_amdgcn_fence(__ATOMIC_RELEASE, "agent");
            asm volatile("s_waitcnt vmcnt(0)" ::: "memory");
            const unsigned og = xb_add(&bar[XB_TOP], 1u);
            const unsigned tg = og / nx;
            if (og + 1u == (tg + 1u) * nx) xb_add(&bar[XB_TOPGEN], 1u);
            else XB_SPIN(xb_ld(&bar[XB_TOPGEN]) == tg, bar);
            __builtin_amdgcn_fence(__ATOMIC_ACQUIRE, "agent");
            xb_add(&bar[XB_XGEN(b.x)], 1u);
            asm volatile("s_waitcnt vmcnt(0)" ::: "memory");
        } else {
            __builtin_amdgcn_fence(__ATOMIC_ACQUIRE, "agent");
            XB_SPIN(xb_ld(&bar[XB_XGEN(b.x)]) == gen, bar);
            asm volatile("s_waitcnt vmcnt(0)" ::: "memory");
        }
    }
    __syncthreads();
}

struct Args { const float* in[35]; float* out; unsigned char* ws; int ph_lo, ph_hi; };

__device__ __forceinline__ void transpose_tile(const float* Wblk, int N, bf16_t* dst, int Kd, const float* gain, LAS float* scr, int lane, int fp8) {
    float v[64];
#pragma unroll
    for (int k = 0; k < 64; ++k) v[k] = Wblk[(size_t)k * N + lane];
    if (gain) {
#pragma unroll
        for (int k = 0; k < 64; ++k) v[k] *= gain[k]; }
#pragma unroll
    for (int k = 0; k < 64; ++k) scr[k * 65 + lane] = v[k];
    LDS_WAIT(); asm volatile("" ::: "memory");
    if (fp8) { const int c4 = lane & 3; unsigned char* d8 = (unsigned char*)dst;
#pragma unroll
        for (int j = 0; j < 4; ++j) { const int n = (lane >> 2) + 16 * j; const LAS float* s = scr + (16 * c4) * 65 + n; u32x4 o;
            o.x = pk4_fp8(s[0 * 65] * W8_SCALE, s[1 * 65] * W8_SCALE, s[2 * 65] * W8_SCALE, s[3 * 65] * W8_SCALE); o.y = pk4_fp8(s[4 * 65] * W8_SCALE, s[5 * 65] * W8_SCALE, s[6 * 65] * W8_SCALE, s[7 * 65] * W8_SCALE);
            o.z = pk4_fp8(s[8 * 65] * W8_SCALE, s[9 * 65] * W8_SCALE, s[10 * 65] * W8_SCALE, s[11 * 65] * W8_SCALE); o.w = pk4_fp8(s[12 * 65] * W8_SCALE, s[13 * 65] * W8_SCALE, s[14 * 65] * W8_SCALE, s[15 * 65] * W8_SCALE);
            *(u32x4*)(d8 + (size_t)n * Kd + 16 * c4) = o; }
        LDS_WAIT(); asm volatile("" ::: "memory"); return; }
    const int c = lane & 7;
#pragma unroll
    for (int j = 0; j < 8; ++j) { const int n = (lane >> 3) + 8 * j; const LAS float* s = scr + (8 * c) * 65 + n;
        u32x4 o; o.x = pk2(s[0 * 65], s[1 * 65]); o.y = pk2(s[2 * 65], s[3 * 65]); o.z = pk2(s[4 * 65], s[5 * 65]); o.w = pk2(s[6 * 65], s[7 * 65]);
        *(u32x4*)(dst + (size_t)n * Kd + 8 * c) = o; }
    LDS_WAIT(); asm volatile("" ::: "memory");
}
__device__ __forceinline__ void transpose_tile_dma(const float* Wblk, int N, unsigned char* d8, int Kd, const float* gain, LAS float* scr, int lane) {
    const unsigned long long wa_ = (unsigned long long)Wblk;
    const unsigned long long wu_ = ((unsigned long long)(unsigned)__builtin_amdgcn_readfirstlane((int)(wa_ >> 32)) << 32) | (unsigned)__builtin_amdgcn_readfirstlane((int)(unsigned)wa_);
    const int Nu = __builtin_amdgcn_readfirstlane(N);
    const __amdgpu_buffer_rsrc_t rw = __builtin_amdgcn_make_buffer_rsrc((void*)wu_, (short)0, 0x7fffffff, 0x00020000);
    const unsigned voff = (unsigned)((lane >> 4) * N * 4 + (lane & 15) * 16);
#pragma unroll
    for (int i = 0; i < 16; ++i)
        __builtin_amdgcn_raw_ptr_buffer_load_lds(rw, (LAS unsigned*)((LAS unsigned char*)scr + i * 1024 + (i >> 2) * 64), 16, voff, (unsigned)(4 * i) * (unsigned)Nu * 4u, 0, 0);
    const int c4 = lane & 3;
    float gs[16];
#pragma unroll
    for (int kk = 0; kk < 16; ++kk) gs[kk] = gain ? gain[16 * c4 + kk] * W8_SCALE : W8_SCALE;
    asm volatile("s_waitcnt vmcnt(0)" ::: "memory");
#pragma unroll
    for (int j = 0; j < 4; ++j) { const int n = (lane >> 2) + 16 * j; const LAS float* sb = (const LAS float*)((const LAS unsigned char*)scr + c4 * (4096 + 64) + n * 4); float t[16];
#pragma unroll
        for (int kk = 0; kk < 16; ++kk) t[kk] = sb[(kk >> 2) * 256 + (kk & 3) * 64] * gs[kk];
        u32x4 o; o.x = pk4_fp8(t[0], t[1], t[2], t[3]); o.y = pk4_fp8(t[4], t[5], t[6], t[7]); o.z = pk4_fp8(t[8], t[9], t[10], t[11]); o.w = pk4_fp8(t[12], t[13], t[14], t[15]);
        *(u32x4*)(d8 + (size_t)n * Kd + 16 * c4) = o; }
    LDS_WAIT(); asm volatile("" ::: "memory");
}
constexpr int CONV8_TILE = 8 * 1024 + 4 * 64;
__device__ __forceinline__ void conv8_issue(const float* Wblk, int N, LAS unsigned char* tile, int lane) {
    const unsigned long long wa_ = (unsigned long long)Wblk;
    const unsigned long long wu_ = ((unsigned long long)(unsigned)__builtin_amdgcn_readfirstlane((int)(wa_ >> 32)) << 32) | (unsigned)__builtin_amdgcn_readfirstlane((int)(unsigned)wa_);
    const int Nu = __builtin_amdgcn_readfirstlane(N);
    const __amdgpu_buffer_rsrc_t rw = __builtin_amdgcn_make_buffer_rsrc((void*)wu_, (short)0, 0x7fffffff, 0x00020000);
    const unsigned voff = (unsigned)((lane >> 3) * Nu * 4 + (lane & 7) * 16);
#pragma unroll
    for (int i = 0; i < 8; ++i)
        __builtin_amdgcn_raw_ptr_buffer_load_lds(rw, (LAS unsigned*)(tile + i * 1024 + (i >> 1) * 64), 16, voff, (unsigned)(8 * i) * (unsigned)Nu * 4u, 0, 0);
}
__device__ __forceinline__ void conv8_finish(const LAS unsigned char* tile, unsigned char* d8, int Kd, const float (&gs)[16], int lane) {
    const int c4 = lane & 3;
#pragma unroll
    for (int j = 0; j < 2; ++j) { const int n = (lane >> 2) + 16 * j; const LAS float* sb = (const LAS float*)(tile + c4 * (2048 + 64) + n * 4); float t[16];
#pragma unroll
        for (int kk = 0; kk < 16; ++kk) t[kk] = sb[(kk >> 3) * 256 + (kk & 7) * 32] * gs[kk];
        u32x4 o; o.x = pk4_fp8(t[0], t[1], t[2], t[3]); o.y = pk4_fp8(t[4], t[5], t[6], t[7]); o.z = pk4_fp8(t[8], t[9], t[10], t[11]); o.w = pk4_fp8(t[12], t[13], t[14], t[15]);
        *(u32x4*)(d8 + (size_t)n * Kd + 16 * c4) = o; }
    LDS_WAIT(); asm volatile("" ::: "memory");
}
__device__ __forceinline__ void rms_row_to_bf16(const float* xrow, bf16_t* orow, int lane) {
    const f32x4* xr = (const f32x4*)xrow + lane;
    f32x4 v[4]; float s = 0.f;
#pragma unroll
    for (int j = 0; j < 4; ++j) { v[j] = xr[64 * j]; s += (v[j].x * v[j].x + v[j].y * v[j].y) + (v[j].z * v[j].z + v[j].w * v[j].w); }
    const float rs = rsqrtf(wave_sum(s) * (1.f / D) + NORM_EPS);
    u32x2* o8 = (u32x2*)orow + lane;
#pragma unroll
    for (int j = 0; j < 4; ++j) { u32x2 w; w.x = pk2(v[j].x * rs, v[j].y * rs); w.y = pk2(v[j].z * rs, v[j].w * rs); o8[64 * j] = w; }
}
template <int R> __device__ __forceinline__ void rms_rows_to_bf16(const float* xrow, bf16_t* orow, int lane, float* inv) {
    const f32x4* xr = (const f32x4*)xrow + lane;
    f32x4 v[4 * R]; float rs[R];
#pragma unroll
    for (int j = 0; j < 4 * R; ++j) v[j] = xr[64 * j];
#pragma unroll
    for (int r = 0; r < R; ++r) { float s = 0.f;
#pragma unroll
        for (int j = 0; j < 4; ++j) { const f32x4 t = v[4 * r + j]; s += (t.x * t.x + t.y * t.y) + (t.z * t.z + t.w * t.w); }
        rs[r] = rsqrtf(wave_sum(s) * (1.f / D) + NORM_EPS);
        if (lane == 0) inv[r] = __builtin_amdgcn_rcpf(rs[r]); }
    u32x2* o8 = (u32x2*)orow + lane;
#pragma unroll
    for (int j = 0; j < 4 * R; ++j) { const float q = rs[j >> 2]; u32x2 w; w.x = pk2(v[j].x * q, v[j].y * q); w.y = pk2(v[j].z * q, v[j].w * q); o8[64 * j] = w; }
}
__device__ __forceinline__ void sincos_red(float ang, float& c, float& s) {
    const float k = rintf(ang * 0.15915494309189535f);
    float r = fmaf(-k, 6.2831854820251465f, ang); r = fmaf(-k, -1.7484555e-7f, r);
    c = __cosf(r); s = __sinf(r);
}

constexpr int NWAVES = 8;
constexpr int N_PHASES = 14;

__global__ void __launch_bounds__(NWAVES * 64, 2) hymba_fwd(Args args) {
    extern __shared__ __attribute__((aligned(16))) unsigned char lds_raw[];
    LAS unsigned char* lds = (LAS unsigned char*)lds_raw;
    volatile LAS unsigned* MISC = (volatile LAS unsigned*)(lds + MISC_OFF);
    const int tid = threadIdx.x, lane = tid & 63, wave = __builtin_amdgcn_readfirstlane(tid >> 6), fr = lane & 15, fq = lane >> 4;
    const int G = gridDim.x, bx = blockIdx.x;
    const int vcu = (G % 8 == 0) ? (bx % 8) * (G / 8) + bx / 8 : bx;
    const int gw = vcu * NWAVES + wave, NGW = G * NWAVES;
    unsigned char* ws = args.ws;
    unsigned* ctl = (unsigned*)(ws + WS_CTL);
    typedef const float* cfp_t;
    const __attribute__((address_space(4))) cfp_t* kargs0 = (const __attribute__((address_space(4))) cfp_t*)__builtin_amdgcn_kernarg_segment_ptr();
    float* OUT = args.out;
    for (int u = tid; u < (LDS_BYTES - RING_BYTES) / 4; u += NWAVES * 64) ((LAS unsigned*)(lds + RING_BYTES))[u] = 0u;
    __syncthreads();
    XcdBarrier bar; bar.bar = ctl + CW_BAR; bar.x = 0; bar.st = nullptr; bar.rank = 0u;
    const int lo = args.ph_lo, hi = args.ph_hi;
    if (MK_N_LAUNCHES == 1 || (lo <= 11 && 11 < hi)) { bar = xcd_barrier_post(ctl + CW_BAR, MISC + 8, tid == 0); if (tid == 0) MISC[12] = bar.rank; }
#define IN(k) (lo <= (k) && (k) < hi)
#define PHASE_IDS() int tid = wave * 64 + lane_id(); asm volatile("" : "+v"(tid)); const int lane = tid & 63, fr = lane & 15, fq = lane >> 4; (void)fr; (void)fq; \
    const __attribute__((address_space(4))) cfp_t* ka = kargs0; asm volatile("" : "+s"(ka)); GAS unsigned char* wsl = (GAS unsigned char*)ws; asm volatile("" : "+s"(wsl)); (void)ka; (void)wsl
#define SEAM(k) do { if (IN(k) && IN((k) + 1)) xcd_barrier(bar, wave == 0 && lane_id() == 0); } while (0)

    constexpr int CONV_MOVE = 6;
    constexpr int I_IN = 16 * 24, I_SQ = 16 * 16, I_KV = 16 * 32, I_GU = 16 * 64, I_DN = 16 * 32;
    constexpr int E0 = I_IN, E1 = E0 + I_SQ, E2 = E1 + I_SQ, E3 = E2 + I_SQ, E4 = E3 + I_KV, E6 = E4 + 16, E7 = E6 + NE * I_GU, E8 = E7 + NE * I_DN;
#define CONV_ITEM(it) do { \
            const float* W; const float* gain = nullptr; bf16_t* dstm; int K = 1024, N, r; int rowmap = 0, f8 = 0; \
            if (it < E0) { W = ((const float*)(const GAS float*)(ka[3])); N = NPROJ; gain = ((const float*)(const GAS float*)(ka[2])); dstm = ((bf16_t*)(GAS bf16_t*)(wsl + WS_WIN)); r = it; } \
            else if (it < E1) { W = ((const float*)(const GAS float*)(ka[21])); N = D; dstm = ((bf16_t*)(GAS bf16_t*)(wsl + WS_WOUT)); r = it - E0; } \
            else if (it < E2) { W = ((const float*)(const GAS float*)(ka[24])); N = D; gain = ((const float*)(const GAS float*)(ka[22])); dstm = ((bf16_t*)(GAS bf16_t*)(wsl + WS_WQ)); r = it - E1; } \
            else if (it < E3) { W = ((const float*)(const GAS float*)(ka[26])); N = D; dstm = ((bf16_t*)(GAS bf16_t*)(wsl + WS_WO)); r = it - E2; } \
            else if (it < E4) { W = ((const float*)(const GAS float*)(ka[25])); N = 2 * D; gain = ((const float*)(const GAS float*)(ka[23])); dstm = ((bf16_t*)(GAS bf16_t*)(wsl + WS_WKV)); r = it - E3; } \
            else if (it < E6) { const int q = it - E4, mat = q >> 3, hh = q & 7; r = 0; K = 64; N = 64; \
                W = (mat ? ((const float*)(const GAS float*)(ka[8])) : ((const float*)(const GAS float*)(ka[6]))) + (size_t)hh * 4096; dstm = ((bf16_t*)(GAS bf16_t*)(wsl + WS_RGWT)) + (size_t)(mat * 8 + hh) * 4096; } \
            else if (it < E7) { const int q = it - E6, e = q / I_GU; r = q % I_GU; N = 2 * D; gain = ((const float*)(const GAS float*)(ka[27])); rowmap = 1; f8 = 1; \
                W = ((const float*)(const GAS float*)(ka[30])) + (size_t)e * D * 2 * D; dstm = (bf16_t*)((unsigned char*)((bf16_t*)(GAS bf16_t*)(wsl + WS_WGU)) + (size_t)e * 2 * D * D); } \
            else { const int q = it - E7, e = q / I_DN; r = q % I_DN; N = D; f8 = 1; W = ((const float*)(const GAS float*)(ka[32])) + (size_t)e * D * D; dstm = (bf16_t*)((unsigned char*)((bf16_t*)(GAS bf16_t*)(wsl + WS_WDN)) + (size_t)e * D * D); } \
            const int nblk = N / 64, kb = r / nblk, nb = r % nblk, k0 = 64 * kb, n0 = 64 * nb; \
            int dn0 = n0; if (rowmap) dn0 = ((n0 & 1023) >> 7) * 256 + (n0 >> 10) * 128 + (n0 & 127); \
            bf16_t* dptr = f8 ? (bf16_t*)((unsigned char*)dstm + (size_t)dn0 * K + k0) : dstm + (size_t)dn0 * K + k0; \
            transpose_tile(W + (size_t)k0 * N + n0, N, dptr, K, gain ? gain + k0 : nullptr, scr, lane, 0); \
        } while (0)
#define CONV8_DECODE(it, src_, N_, d8_, gn_) do { int r_, rm_ = 0; const float* W_; unsigned char* dst_; const float* g_ = nullptr; \
            if ((it) < E7) { const int q_ = (it) - E6, e_ = q_ / I_GU; r_ = q_ % I_GU; N_ = 2 * D; g_ = ((const float*)(const GAS float*)(ka[27])); rm_ = 1; \
                W_ = ((const float*)(const GAS float*)(ka[30])) + (size_t)e_ * D * 2 * D; dst_ = (unsigned char*)(wsl + WS_WGU) + (size_t)e_ * 2 * D * D; } \
            else { const int q_ = (it) - E7, e_ = q_ / I_DN; r_ = q_ % I_DN; N_ = D; W_ = ((const float*)(const GAS float*)(ka[32])) + (size_t)e_ * D * D; dst_ = (unsigned char*)(wsl + WS_WDN) + (size_t)e_ * D * D; } \
            const int nblk_ = N_ / 32, kb_ = r_ / nblk_, nb_ = r_ % nblk_, k0_ = 64 * kb_, n0_ = 32 * nb_; \
            int dn0_ = n0_; if (rm_) dn0_ = ((n0_ & 1023) >> 7) * 256 + (n0_ >> 10) * 128 + (n0_ & 127); \
            src_ = W_ + (size_t)k0_ * N_ + n0_; d8_ = dst_ + (size_t)dn0_ * D + k0_; gn_ = g_ ? g_ + k0_ : nullptr; } while (0)
#define CONV8_PIPE(CNT, IT) do { LAS unsigned char* tl0_ = lds + wave * (2 * CONV8_TILE); const int cnt_ = (CNT); \
            const float* csrc_ = nullptr; int cN_ = 0; unsigned char* cd8_ = nullptr; const float* cg_ = nullptr; \
            if (cnt_ > 0) { const int i0_ = IT(0); CONV8_DECODE(i0_, csrc_, cN_, cd8_, cg_); conv8_issue(csrc_, cN_, tl0_, lane); } \
            for (int s_ = 0; s_ < cnt_; ++s_) { LAS unsigned char* tc_ = tl0_ + (s_ & 1) * CONV8_TILE; LAS unsigned char* tn_ = tl0_ + ((s_ & 1) ^ 1) * CONV8_TILE; \
                float gs_[16]; _Pragma("unroll") for (int kk = 0; kk < 16; ++kk) gs_[kk] = cg_ ? cg_[16 * (lane & 3) + kk] * W8_SCALE : W8_SCALE; \
                const float* nsrc_ = nullptr; int nN_ = 0; unsigned char* nd8_ = nullptr; const float* ng_ = nullptr; \
                if (s_ + 1 < cnt_) { const int i1_ = IT(s_ + 1); CONV8_DECODE(i1_, nsrc_, nN_, nd8_, ng_); conv8_issue(nsrc_, nN_, tn_, lane); asm volatile("s_waitcnt vmcnt(8)" ::: "memory"); } \
                else asm volatile("s_waitcnt vmcnt(0)" ::: "memory"); \
                conv8_finish(tc_, cd8_, D, gs_, lane); \
                csrc_ = nsrc_; cN_ = nN_; cd8_ = nd8_; cg_ = ng_; } } while (0)
    if (IN(0)) { PHASE_IDS();
        LAS float* scr = (LAS float*)(lds + wave * (2 * CONV8_TILE));
        const int nmv = (G > 64) ? (G - 64) * NWAVES * CONV_MOVE : 0;
        for (int it = gw; it < E6; it += NGW) CONV_ITEM(it);
        { const int nf8_ = E8 - nmv - E6;
          const int gwr_ = (gw + NGW - (E6 % NGW)) % NGW;
#define P0_IT(s) (E6 + gwr_ + (s) * NGW)
          CONV8_PIPE(nf8_ > gwr_ ? (nf8_ - gwr_ + NGW - 1) / NGW : 0, P0_IT);
#undef P0_IT
        }
        for (int m = 4 * gw; m < M; m += 4 * NGW) rms_rows_to_bf16<4>(((const float*)(const GAS float*)(ka[0])) + (size_t)m * D, ((bf16_t*)(GAS bf16_t*)(wsl + WS_XB)) + (size_t)m * D, lane, ((float*)(GAS float*)(wsl + WS_XINV)) + m);
        for (int m = gw; m < BATCH * MEMLEN; m += NGW) rms_row_to_bf16(((const float*)(const GAS float*)(ka[1])) + (size_t)m * D, ((bf16_t*)(GAS bf16_t*)(wsl + WS_MEMB)) + (size_t)m * D, lane);
        const int gt = bx * (NWAVES * 64) + tid, NT_ = G * NWAVES * 64;
        for (int i = gt; i < NE * D; i += NT_) { const int n = i >> 10, k = i & 1023; ((bf16_t*)(GAS bf16_t*)(wsl + WS_WRT))[i] = f2bf(((const float*)(const GAS float*)(ka[28]))[(size_t)k * NE + n] * ((const float*)(const GAS float*)(ka[27]))[k]); }
        for (int i = gt; i < 512; i += NT_) { const float l = -((const float*)(const GAS float*)(ka[10]))[i]; ((float*)(GAS float*)(wsl + WS_SP8))[i] = 8.f * (fmaxf(l, 0.f) + log1pf(__expf(-fabsf(l)))); }
        for (int i = gt; i < NE * 64; i += NT_) { const int g = i >> 6; const float dt = __expf(((const float*)(const GAS float*)(ka[18]))[g]), lre = ((const float*)(const GAS float*)(ka[11]))[i], lim = ((const float*)(const GAS float*)(ka[12]))[i];
            float c, s; sincos_red(dt * lim, c, s); const float mg = __expf(dt * lre); ((float*)(GAS float*)(wsl + WS_S5A))[2 * i] = mg * c; ((float*)(GAS float*)(wsl + WS_S5A))[2 * i + 1] = mg * s;
            sincos_red((float)S5_TCH * (dt * lim), c, s); const float mgl = __expf((float)S5_TCH * dt * lre); ((float*)(GAS float*)(wsl + WS_S5AL))[2 * i] = mgl * c; ((float*)(GAS float*)(wsl + WS_S5AL))[2 * i + 1] = mgl * s; }
        for (int i = gt; i < NE * 128 * 32; i += NT_) { const int k = i & 31, n = (i >> 5) & 127, g = i >> 12, p = n & 63; float v = 0.f;
            if (k < 16) { const int gp = g * 64 + p; const float dt = __expf(((const float*)(const GAS float*)(ka[18]))[g]), lre = ((const float*)(const GAS float*)(ka[11]))[gp], lim = ((const float*)(const GAS float*)(ka[12]))[gp];
                float c, s; sincos_red(dt * lim, c, s); const float xr = dt * lre, em1 = expm1f(xr), sh = __sinf(0.5f * (dt * lim - 6.2831853f * rintf(dt * lim * 0.15915494f)));
                const float mg = em1 + 1.f; const float nre = em1 * c - 2.f * sh * sh, aim = mg * s;
                const float den = lre * lre + lim * lim; const float cre = (nre * lre + aim * lim) / den, cim = (aim * lre - nre * lim) / den;
                const float br = ((const float*)(const GAS float*)(ka[13]))[(size_t)gp * 16 + k], bi = ((const float*)(const GAS float*)(ka[14]))[(size_t)gp * 16 + k];
                v = (n < 64) ? (cre * br - cim * bi) : (cre * bi + cim * br); }
            ((bf16_t*)(GAS bf16_t*)(wsl + WS_S5BT))[i] = f2bf(v); }
        for (int i = gt; i < NE * 128 * 256; i += NT_) { const int k = i & 255, n = (i >> 8) & 127, g = i >> 15, p = n & 63, cc = k & 15, j = 15 - (k >> 4);
            const int gp = g * 64 + p; const float dt = __expf(((const float*)(const GAS float*)(ka[18]))[g]), lre = ((const float*)(const GAS float*)(ka[11]))[gp], lim = ((const float*)(const GAS float*)(ka[12]))[gp];
            float c, s; sincos_red(dt * lim, c, s); const float xr = dt * lre, em1 = expm1f(xr), sh = __sinf(0.5f * (dt * lim - 6.2831853f * rintf(dt * lim * 0.15915494f)));
            const float mg = em1 + 1.f; const float nre = em1 * c - 2.f * sh * sh, aim = mg * s;
            const float den = lre * lre + lim * lim; const float cre = (nre * lre + aim * lim) / den, cim = (aim * lre - nre * lim) / den;
            const float br = ((const float*)(const GAS float*)(ka[13]))[(size_t)gp * 16 + cc], bi = ((const float*)(const GAS float*)(ka[14]))[(size_t)gp * 16 + cc];
            const float Br = cre * br - cim * bi, Bi = cre * bi + cim * br;
            float pc, ps; sincos_red((float)j * (dt * lim), pc, ps); const float pm = __expf((float)j * xr); const float pr = pm * pc, pi = pm * ps;
            ((bf16_t*)(GAS bf16_t*)(wsl + WS_S5MT))[i] = f2bf((n < 64) ? (pr * Br - pi * Bi) : (pr * Bi + pi * Br)); }
        for (int i = gt; i < NE * 16 * 128; i += NT_) { const int n = i & 127, c = (i >> 7) & 15, g = i >> 11;
            const float v = (n & 1) ? -((const float*)(const GAS float*)(ka[16]))[(size_t)(g * 16 + c) * 64 + (n >> 1)] : ((const float*)(const GAS float*)(ka[15]))[(size_t)(g * 16 + c) * 64 + (n >> 1)]; ((bf16_t*)(GAS bf16_t*)(wsl + WS_S5CT))[i] = f2bf(v); }
        for (int i = gt; i < NE * 16 * 32; i += NT_) { const int ks = i & 31, d = (i >> 5) & 15, g = i >> 9, q = ks >> 3, j = ks & 7;
            const float v = (j < 4) ? ((const float*)(const GAS float*)(ka[19]))[(size_t)(g * 16 + 4 * q + j) * 16 + d] : 0.f; ((bf16_t*)(GAS bf16_t*)(wsl + WS_S5GT))[i] = f2bf(v); }
    }
    SEAM(0);

    if (IN(1)) { PHASE_IDS();
        { pg8::Gemm g{((bf16_t*)(GAS bf16_t*)(wsl + WS_XB)), ((bf16_t*)(GAS bf16_t*)(wsl + WS_WIN)), 2 * D}; pg8::StaticOrder S; S.init(M, NPROJ, G, bx); pg8::EpiBf16<0> E{nullptr, ((bf16_t*)(GAS bf16_t*)(wsl + WS_PROJ)), NPROJ, nullptr, 1.f};
          pg8::gemm_phase<pg8::EpiBf16<0>, pg8::StaticOrder, false, true>(lds, g, S, E, wave); }
    }
    SEAM(1);

#define WLB() do { asm volatile("s_waitcnt lgkmcnt(0)" ::: "memory"); } while (0)
#define RG_PART(FINAL) do { \
      LAS unsigned char* wl = lds + wave * 12800; LAS bf16_t* XC = (LAS bf16_t*)wl; LAS float* RT = (LAS float*)(wl + 2304); LAS float* IT = (LAS float*)(wl + 6656); (void)XC; (void)IT; \
      const int ch = wave * 64 + lane, h = wave; \
        \
      const __amdgpu_buffer_rsrc_t rPJ = __builtin_amdgcn_make_buffer_rsrc((void*)(unsigned char*)(wsl + WS_PROJ), (short)0, 0x7fffffff, 0x00020000); \
      const __amdgpu_buffer_rsrc_t rST = __builtin_amdgcn_make_buffer_rsrc((void*)(unsigned char*)(wsl + WS_QB), (short)0, 0x7fffffff, 0x00020000); (void)rST; \
      if (FINAL) {   \
        for (int item = bx; item < BATCH * RG_NCH; item += G) { \
          const int b = item / RG_NCH, c = item % RG_NCH; const size_t row0 = (size_t)b * SEQ + c * RG_TCH; \
          float hst = ((float*)(GAS float*)(wsl + WS_RGHIN))[(size_t)item * 512 + ch]; \
          unsigned abn[16]; bf16_t gn_[16]; \
          _Pragma("unroll") for (int i = 0; i < 16; ++i) { abn[i] = (unsigned)__builtin_amdgcn_raw_buffer_load_b32(rST, ch * 4, (int)(row0 + i) * 2048, 0); gn_[i] = (bf16_t)__builtin_amdgcn_raw_buffer_load_b16(rPJ, ch * 2, (int)(row0 + i) * (NPROJ * 2), 0); } \
          for (int sub = 0; sub < 8; ++sub) { \
              const size_t rb = row0 + 16 * sub; LAS bf16_t* YB = (LAS bf16_t*)wl; \
              unsigned ab[16]; float gt_[16]; \
              _Pragma("unroll") for (int i = 0; i < 16; ++i) { ab[i] = abn[i]; gt_[i] = bf2f(gn_[i]); } \
              if (sub < 7) { _Pragma("unroll") for (int i = 0; i < 16; ++i) { abn[i] = (unsigned)__builtin_amdgcn_raw_buffer_load_b32(rST, ch * 4, (int)(rb + 16 + i) * 2048, 0); gn_[i] = (bf16_t)__builtin_amdgcn_raw_buffer_load_b16(rPJ, ch * 2, (int)(rb + 16 + i) * (NPROJ * 2), 0); } } \
              _Pragma("unroll") for (int i = 0; i < 16; i += 2) { \
                  f32x2 a2; a2.x = __builtin_amdgcn_exp2f(bflo(ab[i])); a2.y = __builtin_amdgcn_exp2f(bflo(ab[i + 1])); \
                  hst = a2.x * hst + bfhi(ab[i]); const float h0 = hst; hst = a2.y * hst + bfhi(ab[i + 1]); const float h1 = hst; \
                  f32x2 gt2; gt2.x = gt_[i]; gt2.y = gt_[i + 1]; const f32x2 q2 = (gt2 + (gt2 * gt2) * gt2 * 0.044715f) * (-1.5957691216057308f * 1.44269504f); \
                  f32x2 eq; eq.x = __builtin_amdgcn_exp2f(q2.x); eq.y = __builtin_amdgcn_exp2f(q2.y); const f32x2 dq = eq + 1.0f; \
                  YB[i * 72 + lane] = f2bf(h0 * gt2.x * __builtin_amdgcn_rcpf(dq.x)); YB[(i + 1) * 72 + lane] = f2bf(h1 * gt2.y * __builtin_amdgcn_rcpf(dq.y)); } \
              WLB(); \
              _Pragma("unroll") for (int j = 0; j < 2; ++j) { const int p = lane + 64 * j, yr = p >> 3, yc = (p & 7) * 8; \
                  *(u32x4*)(((bf16_t*)(GAS bf16_t*)(wsl + WS_YCAT)) + (rb + yr) * D + h * 64 + yc) = *(const LAS u32x4*)(YB + yr * 72 + yc); } \
              WLB(); \
          } } } \
      else { \
      const float cw0 = ((const float*)(const GAS float*)(ka[4]))[ch], cw1 = ((const float*)(const GAS float*)(ka[4]))[512 + ch], cw2 = ((const float*)(const GAS float*)(ka[4]))[1024 + ch], cw3 = ((const float*)(const GAS float*)(ka[4]))[1536 + ch], cbias = ((const float*)(const GAS float*)(ka[5]))[ch]; \
      const float ba = ((const float*)(const GAS float*)(ka[7]))[ch], bxx = ((const float*)(const GAS float*)(ka[9]))[ch], ksp = -1.44269504f * ((float*)(GAS float*)(wsl + WS_SP8))[ch]; \
      bf16x8 wa[4][2], wx[4][2]; \
      _Pragma("unroll") for (int nt = 0; nt < 4; ++nt) _Pragma("unroll") for (int ks = 0; ks < 2; ++ks) { \
          wa[nt][ks] = *(const bf16x8*)(((bf16_t*)(GAS bf16_t*)(wsl + WS_RGWT)) + (size_t)(h * 64 + 16 * nt + fr) * 64 + 32 * ks + 8 * fq); \
          wx[nt][ks] = *(const bf16x8*)(((bf16_t*)(GAS bf16_t*)(wsl + WS_RGWT)) + (size_t)((8 + h) * 64 + 16 * nt + fr) * 64 + 32 * ks + 8 * fq); } \
      for (int item = bx; item < BATCH * RG_NCH; item += G) { \
          const int b = item / RG_NCH, c = item % RG_NCH, t0 = c * RG_TCH; const size_t row0 = (size_t)b * SEQ + t0; \
          float xm3 = 0.f, xm2 = 0.f, xm1 = 0.f; \
          if (t0 > 0) { xm3 = bf2f(((bf16_t*)(GAS bf16_t*)(wsl + WS_PROJ))[(row0 - 3) * NPROJ + 512 + ch]); xm2 = bf2f(((bf16_t*)(GAS bf16_t*)(wsl + WS_PROJ))[(row0 - 2) * NPROJ + 512 + ch]); xm1 = bf2f(((bf16_t*)(GAS bf16_t*)(wsl + WS_PROJ))[(row0 - 1) * NPROJ + 512 + ch]); } \
          float hst = 0.f, pacc = 1.f; \
          bf16_t xn_[16]; \
          _Pragma("unroll") for (int i = 0; i < 16; ++i) xn_[i] = (bf16_t)__builtin_amdgcn_raw_buffer_load_b16(rPJ, (512 + ch) * 2, (int)(row0 + i) * (NPROJ * 2), 0); \
          for (int sub = 0; sub < 8; ++sub) { \
              const size_t rb = row0 + 16 * sub; \
              float xr[16], xc[16]; \
              _Pragma("unroll") for (int i = 0; i < 16; ++i) xr[i] = bf2f(xn_[i]); \
              if (sub < 7) { _Pragma("unroll") for (int i = 0; i < 16; ++i) xn_[i] = (bf16_t)__builtin_amdgcn_raw_buffer_load_b16(rPJ, (512 + ch) * 2, (int)(rb + 16 + i) * (NPROJ * 2), 0); } \
              _Pragma("unroll") for (int i = 0; i < 16; ++i) { xc[i] = cw0 * xm3 + cw1 * xm2 + cw2 * xm1 + cw3 * xr[i] + cbias; xm3 = xm2; xm2 = xm1; xm1 = xr[i]; XC[i * 72 + lane] = f2bf(xc[i]); } \
              WLB(); \
              { const bf16x8 a0 = *(const LAS bf16x8*)(XC + fr * 72 + 8 * fq), a1 = *(const LAS bf16x8*)(XC + fr * 72 + 32 + 8 * fq); \
                _Pragma("unroll") for (int nt = 0; nt < 4; ++nt) { f32x4 r = {0.f, 0.f, 0.f, 0.f}, q = {0.f, 0.f, 0.f, 0.f}; \
                    r = __builtin_amdgcn_mfma_f32_16x16x32_bf16(wa[nt][0], a0, r, 0, 0, 0); r = __builtin_amdgcn_mfma_f32_16x16x32_bf16(wa[nt][1], a1, r, 0, 0, 0); \
                    q = __builtin_amdgcn_mfma_f32_16x16x32_bf16(wx[nt][0], a0, q, 0, 0, 0); q = __builtin_amdgcn_mfma_f32_16x16x32_bf16(wx[nt][1], a1, q, 0, 0, 0); \
                    *(LAS f32x4*)(RT + fr * 68 + 16 * nt + 4 * fq) = r; *(LAS f32x4*)(IT + fr * 68 + 16 * nt + 4 * fq) = q; } } \
              WLB(); \
              _Pragma("unroll") for (int i = 0; i < 16; i += 2) {   \
                  f32x2 rp, ip; rp.x = RT[i * 68 + lane]; rp.y = RT[(i + 1) * 68 + lane]; ip.x = IT[i * 68 + lane]; ip.y = IT[(i + 1) * 68 + lane]; \
                  const f32x2 tr = (rp + ba) * (-1.44269504f), ti = (ip + bxx) * (-1.44269504f); \
                  f32x2 er, ei; er.x = __builtin_amdgcn_exp2f(tr.x); er.y = __builtin_amdgcn_exp2f(tr.y); ei.x = __builtin_amdgcn_exp2f(ti.x); ei.y = __builtin_amdgcn_exp2f(ti.y); \
                  const f32x2 dr = er + 1.0f, di = ei + 1.0f; \
                  f32x2 r2, g2; r2.x = __builtin_amdgcn_rcpf(dr.x); r2.y = __builtin_amdgcn_rcpf(dr.y); g2.x = __builtin_amdgcn_rcpf(di.x); g2.y = __builtin_amdgcn_rcpf(di.y); \
                  const f32x2 la = r2 * ksp; f32x2 a2; a2.x = __builtin_amdgcn_exp2f(la.x); a2.y = __builtin_amdgcn_exp2f(la.y);     \
                  const f32x2 m2 = 1.0f - a2 * a2; f32x2 mu; mu.x = __builtin_amdgcn_sqrtf(fmaxf(m2.x, 0.f)); mu.y = __builtin_amdgcn_sqrtf(fmaxf(m2.y, 0.f)); \
                  if (t0 + 16 * sub + i == 0) mu.x = 1.f; \
                  f32x2 xc2; xc2.x = xc[i]; xc2.y = xc[i + 1]; const f32x2 b2 = (mu * g2) * xc2; \
                  hst = a2.x * hst + b2.x; hst = a2.y * hst + b2.y; pacc *= a2.x * a2.y; \
                  ((LAS unsigned*)RT)[i * 68 + lane] = pk2(la.x, b2.x); ((LAS unsigned*)RT)[(i + 1) * 68 + lane] = pk2(la.y, b2.y); }     \
              WLB(); \
              _Pragma("unroll") for (int j = 0; j < 4; ++j) { const int p = lane + 64 * j, yr = p >> 4, yc = (p & 15) * 4; \
                  *(u32x4*)(((unsigned*)(GAS unsigned*)(wsl + WS_QB)) + (rb + yr) * 512 + h * 64 + yc) = *(const LAS u32x4*)((LAS unsigned*)RT + yr * 68 + yc); } \
              WLB(); \
          } \
          ((float*)(GAS float*)(wsl + WS_RGP))[(size_t)item * 512 + ch] = pacc; ((float*)(GAS float*)(wsl + WS_RGH))[(size_t)item * 512 + ch] = hst; \
      } } } while (0)
#define S5_PART(FINAL) do { \
    { LAS float* BU = (LAS float*)(lds + wave * 12800); LAS bf16_t* HT = (LAS bf16_t*)(lds + wave * 12800 + 8448); \
      for (int item = gw; item < BATCH * NE * S5_NCH; item += NGW) { \
          const int c = item % S5_NCH, g = (item / S5_NCH) % NE, b = item / (S5_NCH * NE); \
          const float are = ((float*)(GAS float*)(wsl + WS_S5A))[2 * (g * 64 + lane)], aim = ((float*)(GAS float*)(wsl + WS_S5A))[2 * (g * 64 + lane) + 1]; \
          bf16x8 btf[8]; _Pragma("unroll") for (int nt = 0; nt < 8; ++nt) btf[nt] = *(const bf16x8*)(((bf16_t*)(GAS bf16_t*)(wsl + WS_S5BT)) + (size_t)(g * 128 + 16 * nt + fr) * 32 + 8 * fq); \
          bf16x8 ctf[4], gtf; f32x4 dsk, gbv; \
          if (FINAL) { _Pragma("unroll") for (int ks = 0; ks < 4; ++ks) ctf[ks] = *(const bf16x8*)(((bf16_t*)(GAS bf16_t*)(wsl + WS_S5CT)) + (size_t)(g * 16 + fr) * 128 + 32 * ks + 8 * fq); \
              gtf = *(const bf16x8*)(((bf16_t*)(GAS bf16_t*)(wsl + WS_S5GT)) + (size_t)(g * 16 + fr) * 32 + 8 * fq); dsk = *(const f32x4*)(((const float*)(const GAS float*)(ka[17])) + 16 * g + 4 * fq); gbv = *(const f32x4*)(((const float*)(const GAS float*)(ka[20])) + 16 * g + 4 * fq); } \
          float hre = 0.f, him = 0.f; if (FINAL) { hre = ((float*)(GAS float*)(wsl + WS_S5HIN))[(size_t)item * 128 + lane]; him = ((float*)(GAS float*)(wsl + WS_S5HIN))[(size_t)item * 128 + 64 + lane]; } \
          const size_t row0 = (size_t)b * SEQ + (size_t)c * S5_TCH; \
          bf16x8 ufn = {0, 0, 0, 0, 0, 0, 0, 0}; if (fq < 2) ufn = *(const bf16x8*)(((bf16_t*)(GAS bf16_t*)(wsl + WS_PROJ)) + (row0 + fr) * NPROJ + 1024 + 16 * g + 8 * fq); \
          u32x2 urn = {0u, 0u}; if (FINAL) urn = *(const u32x2*)(((bf16_t*)(GAS bf16_t*)(wsl + WS_PROJ)) + (row0 + fr) * NPROJ + 1024 + 16 * g + 4 * fq); \
          for (int it = 0; it < S5_TCH / 16; ++it) { \
              const size_t rb = row0 + 16 * it; \
              const bf16x8 uf = ufn; const u32x2 uraw = urn; \
              if (it + 1 < S5_TCH / 16) { if (fq < 2) ufn = *(const bf16x8*)(((bf16_t*)(GAS bf16_t*)(wsl + WS_PROJ)) + (rb + 16 + fr) * NPROJ + 1024 + 16 * g + 8 * fq); \
                  if (FINAL) urn = *(const u32x2*)(((bf16_t*)(GAS bf16_t*)(wsl + WS_PROJ)) + (rb + 16 + fr) * NPROJ + 1024 + 16 * g + 4 * fq); } \
              _Pragma("unroll") for (int nt = 0; nt < 8; ++nt) { f32x4 a4 = {0.f, 0.f, 0.f, 0.f}; a4 = __builtin_amdgcn_mfma_f32_16x16x32_bf16(btf[nt], uf, a4, 0, 0, 0); \
                  *(LAS f32x4*)(BU + fr * 132 + 16 * nt + 4 * fq) = a4; } \
              LDS_WAIT(); \
              float bre_[16], bim_[16]; \
              _Pragma("unroll") for (int i = 0; i < 16; ++i) { bre_[i] = BU[i * 132 + lane]; bim_[i] = BU[i * 132 + 64 + lane]; } \
              { f32x2 hv; hv.x = hre; hv.y = him; f32x2 a1; a1.x = are; a1.y = are; f32x2 a2; a2.x = -aim; a2.y = aim;     \
              _Pragma("unroll") for (int i = 0; i < 16; ++i) { f32x2 b2; b2.x = bre_[i]; b2.y = bim_[i]; \
                  const f32x2 hs = __builtin_shufflevector(hv, hv, 1, 0); const f32x2 t2 = a2 * hs + b2; hv = a1 * hv + t2; \
                  if (FINAL) ((LAS unsigned*)HT)[i * 68 + lane] = pk2(hv.x, hv.y); } \
              hre = hv.x; him = hv.y; } \
              if (FINAL) { LDS_WAIT(); \
                  f32x4 y = {0.f, 0.f, 0.f, 0.f}; \
                  _Pragma("unroll") for (int ks = 0; ks < 4; ++ks) { const bf16x8 hf = *(const LAS bf16x8*)(HT + fr * 136 + 32 * ks + 8 * fq); y = __builtin_amdgcn_mfma_f32_16x16x32_bf16(ctf[ks], hf, y, 0, 0, 0); } \
                  f32x4 z; z[0] = gelu_tanh(y[0] + dsk[0] * bflo(uraw.x)); z[1] = gelu_tanh(y[1] + dsk[1] * bfhi(uraw.x)); z[2] = gelu_tanh(y[2] + dsk[2] * bflo(uraw.y)); z[3] = gelu_tanh(y[3] + dsk[3] * bfhi(uraw.y)); \
                  union { bf16x8 v; unsigned w[4]; } zf; zf.w[0] = pk2(z[0], z[1]); zf.w[1] = pk2(z[2], z[3]); zf.w[2] = 0u; zf.w[3] = 0u; \
                  f32x4 gp = {0.f, 0.f, 0.f, 0.f}; gp = __builtin_amdgcn_mfma_f32_16x16x32_bf16(gtf, zf.v, gp, 0, 0, 0); \
                  u32x2 o; o.x = pk2(z[0] * sigmoidf_(gp[0] + gbv[0]), z[1] * sigmoidf_(gp[1] + gbv[1])); o.y = pk2(z[2] * sigmoidf_(gp[2] + gbv[2]), z[3] * sigmoidf_(gp[3] + gbv[3])); \
                  *(u32x2*)(((bf16_t*)(GAS bf16_t*)(wsl + WS_YCAT)) + (rb + fr) * D + 512 + 16 * g + 4 * fq) = o; } \
              LDS_WAIT(); \
          } \
          if (!FINAL) { ((float*)(GAS float*)(wsl + WS_S5H))[(size_t)item * 128 + lane] = hre; ((float*)(GAS float*)(wsl + WS_S5H))[(size_t)item * 128 + 64 + lane] = him; } \
      } } \
} while (0)
#define S5_PART_A() do { \
    { LAS float* BU = (LAS float*)(lds + wave * 12800); \
      for (int item = gw; item < BATCH * NE * S5_NCH; item += NGW) { \
          const int c = item % S5_NCH, g = (item / S5_NCH) % NE, b = item / (S5_NCH * NE); \
          float pr_ = ((float*)(GAS float*)(wsl + WS_S5A))[2 * (g * 64 + lane)], pi_ = ((float*)(GAS float*)(wsl + WS_S5A))[2 * (g * 64 + lane) + 1]; \
          _Pragma("unroll") for (int q = 0; q < 4; ++q) { const float nr_ = pr_ * pr_ - pi_ * pi_, ni_ = 2.f * pr_ * pi_; pr_ = nr_; pi_ = ni_; }     \
          f32x2 a1; a1.x = pr_; a1.y = pr_; f32x2 a2; a2.x = -pi_; a2.y = pi_; f32x2 hv; hv.x = 0.f; hv.y = 0.f; \
          const size_t row0 = (size_t)b * SEQ + (size_t)c * S5_TCH; \
            \
          const __amdgpu_buffer_rsrc_t rMT = __builtin_amdgcn_make_buffer_rsrc((void*)(unsigned char*)(wsl + WS_S5MT), (short)0, 0x7fffffff, 0x00020000); \
          const __amdgpu_buffer_rsrc_t rPU = __builtin_amdgcn_make_buffer_rsrc((void*)(unsigned char*)(wsl + WS_PROJ), (short)0, 0x7fffffff, 0x00020000); \
          const int mvo = (fr * 256 + 8 * fq) * 2, msb = g * 128 * 256 * 2; \
          const int uvo = ((16 * fr + (fq >> 1)) * NPROJ + 8 * (fq & 1)) * 2, usb = (int)(row0 * NPROJ + 1024 + 16 * g) * 2; \
            \
          f32x4 sacc[2][8]; _Pragma("unroll") for (int bt = 0; bt < 2; ++bt) _Pragma("unroll") for (int mt = 0; mt < 8; ++mt) sacc[bt][mt] = (f32x4){0.f, 0.f, 0.f, 0.f}; \
          u32x4 afn[8], ufn[2]; \
          _Pragma("unroll") for (int bt = 0; bt < 2; ++bt) ufn[bt] = __builtin_amdgcn_raw_buffer_load_b128(rPU, uvo, usb + (256 * bt) * (NPROJ * 2), 0); \
          _Pragma("unroll") for (int mt = 0; mt < 8; ++mt) afn[mt] = __builtin_amdgcn_raw_buffer_load_b128(rMT, mvo, msb + (16 * mt * 256) * 2, 0); \
          _Pragma("unroll") for (int ks = 0; ks < 8; ++ks) { u32x4 afc[8], ufc[2]; \
              _Pragma("unroll") for (int mt = 0; mt < 8; ++mt) afc[mt] = afn[mt]; \
              ufc[0] = ufn[0]; ufc[1] = ufn[1]; \
              if (ks < 7) { _Pragma("unroll") for (int bt = 0; bt < 2; ++bt) ufn[bt] = __builtin_amdgcn_raw_buffer_load_b128(rPU, uvo, usb + (256 * bt + 2 * (ks + 1)) * (NPROJ * 2), 0); \
                  _Pragma("unroll") for (int mt = 0; mt < 8; ++mt) afn[mt] = __builtin_amdgcn_raw_buffer_load_b128(rMT, mvo, msb + (16 * mt * 256 + 32 * (ks + 1)) * 2, 0); } \
              asm volatile("" ::: "memory"); \
              _Pragma("unroll") for (int mt = 0; mt < 8; ++mt) { const bf16x8 af = __builtin_bit_cast(bf16x8, afc[mt]); \
                  sacc[0][mt] = __builtin_amdgcn_mfma_f32_16x16x32_bf16(af, __builtin_bit_cast(bf16x8, ufc[0]), sacc[0][mt], 0, 0, 0); \
                  sacc[1][mt] = __builtin_amdgcn_mfma_f32_16x16x32_bf16(af, __builtin_bit_cast(bf16x8, ufc[1]), sacc[1][mt], 0, 0, 0); } \
              asm volatile("" ::: "memory"); } \
          _Pragma("unroll") for (int bt = 0; bt < 2; ++bt) { \
              _Pragma("unroll") for (int mt = 0; mt < 8; ++mt) *(LAS f32x4*)(BU + fr * 132 + 16 * mt + 4 * fq) = sacc[bt][mt]; \
              LDS_WAIT(); \
              _Pragma("unroll") for (int blk = 0; blk < 16; ++blk) { f32x2 b2; b2.x = BU[blk * 132 + lane]; b2.y = BU[blk * 132 + 64 + lane]; \
                  const f32x2 hs = __builtin_shufflevector(hv, hv, 1, 0); const f32x2 t2 = a2 * hs + b2; hv = a1 * hv + t2; } \
              LDS_WAIT(); \
          } \
          ((float*)(GAS float*)(wsl + WS_S5H))[(size_t)item * 128 + lane] = hv.x; ((float*)(GAS float*)(wsl + WS_S5H))[(size_t)item * 128 + 64 + lane] = hv.y; \
      } } \
} while (0)
#define S5_SEL(FINAL) do { if (FINAL) { S5_PART(FINAL); } else { S5_PART_A(); } } while (0)
#define MIXER_PASS(FINAL) do { PHASE_IDS(); if (wave < 4) { S5_SEL(FINAL); RG_PART(FINAL); } else { RG_PART(FINAL); S5_SEL(FINAL); } __syncthreads(); } while (0)


    if (IN(2)) { MIXER_PASS(false); }
    SEAM(2);

    if (IN(3)) { PHASE_IDS();
        if (G >= 64 ? bx >= 32 : true) { pg8::Gemm g{((bf16_t*)(GAS bf16_t*)(wsl + WS_MEMB)), ((bf16_t*)(GAS bf16_t*)(wsl + WS_WKV)), 2 * D}; pg8::StaticOrder S; S.init(BATCH * MEMLEN, 2 * D, G >= 64 ? G - 32 : G, G >= 64 ? bx - 32 : bx); pg8::EpiKV E{((bf16_t*)(GAS bf16_t*)(wsl + WS_KB)), ((bf16_t*)(GAS bf16_t*)(wsl + WS_VT))};
          pg8::gemm_phase<pg8::EpiKV, pg8::StaticOrder, false, true>(lds, g, S, E, wave); }
        const int gt = bx * (NWAVES * 64) + tid;
        if (gt < BATCH * 512) { const int b = gt / 512, ch = gt % 512; float h = 0.f;
            for (int c0 = 0; c0 < RG_NCH; c0 += 16) { float pp[16], hh[16];
#pragma unroll
                for (int j = 0; j < 16; ++j) { const size_t idx = (size_t)(b * RG_NCH + c0 + j) * 512 + ch; pp[j] = ((float*)(GAS float*)(wsl + WS_RGP))[idx]; hh[j] = ((float*)(GAS float*)(wsl + WS_RGH))[idx]; }
#pragma unroll
                for (int j = 0; j < 16; ++j) { const size_t idx = (size_t)(b * RG_NCH + c0 + j) * 512 + ch; ((float*)(GAS float*)(wsl + WS_RGHIN))[idx] = h; h = pp[j] * h + hh[j]; } } }
        else if (gt < BATCH * 512 + BATCH * NE * 64) { const int k = gt - BATCH * 512, p = k & 63, g = (k >> 6) & 31, b = k >> 11;
            const float ar = ((float*)(GAS float*)(wsl + WS_S5AL))[2 * (g * 64 + p)], ai = ((float*)(GAS float*)(wsl + WS_S5AL))[2 * (g * 64 + p) + 1]; float hr = 0.f, hi_ = 0.f;
            float lr[S5_NCH], li[S5_NCH];
#pragma unroll
            for (int c = 0; c < S5_NCH; ++c) { const size_t idx = (size_t)((b * NE + g) * S5_NCH + c) * 128 + p; lr[c] = ((float*)(GAS float*)(wsl + WS_S5H))[idx]; li[c] = ((float*)(GAS float*)(wsl + WS_S5H))[idx + 64]; }
#pragma unroll
            for (int c = 0; c < S5_NCH; ++c) { const size_t idx = (size_t)((b * NE + g) * S5_NCH + c) * 128 + p; ((float*)(GAS float*)(wsl + WS_S5HIN))[idx] = hr; ((float*)(GAS float*)(wsl + WS_S5HIN))[idx + 64] = hi_;
                const float nr = ar * hr - ai * hi_ + lr[c], ni = ar * hi_ + ai * hr + li[c]; hr = nr; hi_ = ni; } }
        if (G > 64 && bx >= 64) {
            LAS float* scr = (LAS float*)(lds + wave * (2 * CONV8_TILE));     const int nw_ = (G - 64) * NWAVES, w0_ = (bx - 64) * NWAVES + wave;
#define P3_IT(s) (E8 - nw_ * CONV_MOVE + (s) * nw_ + w0_)
            CONV8_PIPE(CONV_MOVE, P3_IT);
#undef P3_IT
            (void)scr; }
    }
    SEAM(3);

    if (IN(4)) { MIXER_PASS(true); }
    SEAM(4);

    if (IN(5)) { PHASE_IDS(); pg8::Gemm g{((bf16_t*)(GAS bf16_t*)(wsl + WS_YCAT)), ((bf16_t*)(GAS bf16_t*)(wsl + WS_WOUT)), 2 * D}; pg8::StaticOrder S; S.init(M, D, G, bx); pg8::EpiRes<false> E{((const float*)(const GAS float*)(wsl + WS_XINV)), ((bf16_t*)(GAS bf16_t*)(wsl + WS_HB)), ((float*)(GAS float*)(wsl + WS_SS1)), ((const bf16_t*)(const GAS bf16_t*)(wsl + WS_XB))};
        pg8::gemm_phase<pg8::EpiRes<false>, pg8::StaticOrder, false, true>(lds, g, S, E, wave); }
    SEAM(5);

    if (IN(6)) { PHASE_IDS(); pg8::Gemm g{((bf16_t*)(GAS bf16_t*)(wsl + WS_HB)), ((bf16_t*)(GAS bf16_t*)(wsl + WS_WQ)), 2 * D}; pg8::StaticOrder S; S.init(M, D, G, bx); pg8::EpiBf16<1> E{nullptr, ((bf16_t*)(GAS bf16_t*)(wsl + WS_QB)), D, ((float*)(GAS float*)(wsl + WS_SS1)), QSCALE};
        pg8::gemm_phase<pg8::EpiBf16<1>, pg8::StaticOrder, false, true>(lds, g, S, E, wave); }
    SEAM(6);

    if (IN(7)) { PHASE_IDS();
        constexpr int NIT = NH * (M / 256), RB = M / 256;
        unsigned dsrc[8];
#pragma unroll
        for (int j = 0; j < 8; ++j) { const int lr = 2 * (wave * 8 + j) + (lane >> 5), p = lane & 31, c = ((p ^ lr) & 15) | (p & 16); dsrc[j] = (unsigned)(lr * 512 + c * 16); }
#define ATT_DMA(rs_, half_, buf_) do { _Pragma("unroll") for (int _j = 0; _j < 8; ++_j) \
            __builtin_amdgcn_raw_ptr_buffer_load_lds(rs_, (LAS unsigned*)(lds + (buf_) + (wave * 8 + _j) * 1024), 16, dsrc[_j], (half_) * 65536, 0, 0); } while (0)
#define ATT_SYNC(wait_) do { if (wait_) asm volatile("s_waitcnt vmcnt(0)" ::: "memory"); asm volatile("s_waitcnt lgkmcnt(0)" ::: "memory"); __builtin_amdgcn_s_barrier(); asm volatile("" ::: "memory"); } while (0)
#define ATT_FRAG(buf_, r_, ci_) (*(const LAS bf16x8*)(lds + (buf_) + (r_) * 512 + ((((ci_) ^ (r_)) & 15) | ((ci_) & 16)) * 16))
        int item = bx;
        if (item < NIT) { const int h = item / RB, b = (item % RB) / (SEQ / 256);
            const __amdgpu_buffer_rsrc_t rK = __builtin_amdgcn_make_buffer_rsrc((void*)(((bf16_t*)(GAS bf16_t*)(wsl + WS_KB)) + (size_t)(b * NH + h) * MEMLEN * HD), (short)0, MEMLEN * HD * 2, 0x00020000);
            ATT_DMA(rK, 0, 0); ATT_DMA(rK, 1, 65536); }
        for (; item < NIT; item += G) {
            const int h = item / RB, rblk = item % RB, b = rblk / (SEQ / 256);
            const __amdgpu_buffer_rsrc_t rV = __builtin_amdgcn_make_buffer_rsrc((void*)(((bf16_t*)(GAS bf16_t*)(wsl + WS_VT)) + (size_t)(b * NH + h) * HD * MEMLEN), (short)0, MEMLEN * HD * 2, 0x00020000);
            const size_t rowg = (size_t)rblk * 256 + wave * 32 + fr;
            bf16x8 pf[2][8]; float inv[2];
            ATT_SYNC(true);
#pragma unroll
            for (int g2 = 0; g2 < 2; ++g2) {
                int ro = 16 * g2; if (g2 == 1) asm volatile("" : "+v"(ro) : "v"(inv[0]));
                bf16x8 qf[8];
#pragma unroll
                for (int ks = 0; ks < 8; ++ks) qf[ks] = *(const bf16x8*)(((bf16_t*)(GAS bf16_t*)(wsl + WS_QB)) + (rowg + ro) * D + h * HD + 32 * ks + 8 * fq);
                f32x4 S[16];
#pragma unroll
                for (int mt = 0; mt < 16; ++mt) { S[mt] = (f32x4){0.f, 0.f, 0.f, 0.f};
                    if (g2 == 1 && mt == 8) { ATT_SYNC(false); ATT_DMA(rV, 0, 0); }
#pragma unroll
                    for (int ks = 0; ks < 8; ++ks) { const bf16x8 kf = ATT_FRAG((mt >> 3) * 65536, 16 * (mt & 7) + fr, 4 * ks + fq); S[mt] = __builtin_amdgcn_mfma_f32_16x16x32_bf16(kf, qf[ks], S[mt], 0, 0, 0); } }
                float mx = -3.0e38f;
#pragma unroll
                for (int mt = 0; mt < 16; ++mt) mx = fmaxf(fmaxf(mx, fmaxf(S[mt][0], S[mt][1])), fmaxf(S[mt][2], S[mt][3]));
                mx = fmaxf(mx, __shfl_xor(mx, 16)); mx = fmaxf(mx, __shfl_xor(mx, 32));
                float sum = 0.f;
#pragma unroll
                for (int k2 = 0; k2 < 8; ++k2) { union { bf16x8 v; unsigned w[4]; } pu; float e[8];
#pragma unroll
                    for (int j = 0; j < 4; ++j) { e[j] = __builtin_amdgcn_exp2f(S[2 * k2][j] - mx); e[4 + j] = __builtin_amdgcn_exp2f(S[2 * k2 + 1][j] - mx); }
                    sum += ((e[0] + e[1]) + (e[2] + e[3])) + ((e[4] + e[5]) + (e[6] + e[7]));
                    pu.w[0] = pk2(e[0], e[1]); pu.w[1] = pk2(e[2], e[3]); pu.w[2] = pk2(e[4], e[5]); pu.w[3] = pk2(e[6], e[7]); pf[g2][k2] = pu.v; }
                sum += __shfl_xor(sum, 16); sum += __shfl_xor(sum, 32);
                inv[g2] = __builtin_amdgcn_rcpf(sum);
            }
            ATT_SYNC(true); ATT_DMA(rV, 1, 65536);
            const bool more = item + G < NIT; const int nh = (item + G) / RB, nb = ((item + G) % RB) / (SEQ / 256);
            const __amdgpu_buffer_rsrc_t rKn = __builtin_amdgcn_make_buffer_rsrc((void*)(((bf16_t*)(GAS bf16_t*)(wsl + WS_KB)) + (size_t)((more ? nb : b) * NH + (more ? nh : h)) * MEMLEN * HD), (short)0, MEMLEN * HD * 2, 0x00020000);
#pragma unroll
            for (int hv = 0; hv < 2; ++hv) {
                if (hv == 1) { ATT_SYNC(true); if (more) ATT_DMA(rKn, 0, 0); }
#pragma unroll
                for (int d8 = 0; d8 < 8; ++d8) { f32x4 o0 = {0.f, 0.f, 0.f, 0.f}, o1 = {0.f, 0.f, 0.f, 0.f}; asm volatile("" : "+v"(o0), "+v"(o1));
#pragma unroll
                    for (int k2 = 0; k2 < 8; ++k2) { const bf16x8 vf = ATT_FRAG(hv * 65536, 16 * d8 + fr, 4 * k2 + fq);
                        o0 = __builtin_amdgcn_mfma_f32_16x16x32_bf16(vf, pf[0][k2], o0, 0, 0, 0); o1 = __builtin_amdgcn_mfma_f32_16x16x32_bf16(vf, pf[1][k2], o1, 0, 0, 0); }
                    u32x2 w0, w1; w0.x = pk2(o0[0] * inv[0], o0[1] * inv[0]); w0.y = pk2(o0[2] * inv[0], o0[3] * inv[0]); w1.x = pk2(o1[0] * inv[1], o1[1] * inv[1]); w1.y = pk2(o1[2] * inv[1], o1[3] * inv[1]);
                    *(u32x2*)(((bf16_t*)(GAS bf16_t*)(wsl + WS_OB)) + rowg * D + h * HD + 128 * hv + 16 * d8 + 4 * fq) = w0;
                    *(u32x2*)(((bf16_t*)(GAS bf16_t*)(wsl + WS_OB)) + (rowg + 16) * D + h * HD + 128 * hv + 16 * d8 + 4 * fq) = w1; }
            }
            ATT_SYNC(false); if (more) ATT_DMA(rKn, 1, 65536);
        }
        asm volatile("s_waitcnt vmcnt(0)" ::: "memory");
#undef ATT_DMA
#undef ATT_SYNC
#undef ATT_FRAG
    }
    SEAM(7);

    if (IN(8)) { PHASE_IDS(); pg8::Gemm g{((bf16_t*)(GAS bf16_t*)(wsl + WS_OB)), ((bf16_t*)(GAS bf16_t*)(wsl + WS_WO)), 2 * D}; pg8::StaticOrder S; S.init(M, D, G, bx); pg8::EpiRes<true> E{nullptr, ((bf16_t*)(GAS bf16_t*)(wsl + WS_HB)), ((float*)(GAS float*)(wsl + WS_SS2))};
        pg8::gemm_phase<pg8::EpiRes<true>, pg8::StaticOrder, false, true>(lds, g, S, E, wave); }
    SEAM(8);

    if (IN(9)) { PHASE_IDS();
        LAS float* LG = (LAS float*)(lds + wave * 2112);
        LAS int* HIST = (LAS int*)(lds + 20480); LAS int* BASE = (LAS int*)(lds + 20736);
        for (int blk = bx; blk < M / 128; blk += G) {
            if (tid < NE) HIST[tid] = 0;
            __syncthreads();
            const int m = blk * 128 + wave * 16 + fr;
            f32x4 acc0 = {0.f, 0.f, 0.f, 0.f}, acc1 = {0.f, 0.f, 0.f, 0.f};
            const float rs = rsqrtf(((float*)(GAS float*)(wsl + WS_SS2))[m] * (1.0f / D) + NORM_EPS);
            bf16x8 hf[32];
#pragma unroll
            for (int ks = 0; ks < 32; ++ks) hf[ks] = *(const bf16x8*)(((bf16_t*)(GAS bf16_t*)(wsl + WS_HB)) + (size_t)m * D + 32 * ks + 8 * fq);
#pragma unroll
            for (int kb = 0; kb < 4; ++kb) {
                bf16x8 w0[8], w1[8];
#pragma unroll
                for (int j = 0; j < 8; ++j) { const int ks = 8 * kb + j; w0[j] = *(const bf16x8*)(((bf16_t*)(GAS bf16_t*)(wsl + WS_WRT)) + (size_t)fr * D + 32 * ks + 8 * fq); w1[j] = *(const bf16x8*)(((bf16_t*)(GAS bf16_t*)(wsl + WS_WRT)) + (size_t)(16 + fr) * D + 32 * ks + 8 * fq); }
                asm volatile("" ::: "memory");
#pragma unroll
                for (int j = 0; j < 8; ++j) { acc0 = __builtin_amdgcn_mfma_f32_16x16x32_bf16(w0[j], hf[8 * kb + j], acc0, 0, 0, 0); acc1 = __builtin_amdgcn_mfma_f32_16x16x32_bf16(w1[j], hf[8 * kb + j], acc1, 0, 0, 0); }
                asm volatile("" ::: "memory"); }
#pragma unroll
            for (int ks = 0; ks < 32; ++ks) { const u32x4 hw = __builtin_bit_cast(u32x4, hf[ks]); u32x2 w8; w8.x = pk4_fp8(bflo(hw.x) * rs, bfhi(hw.x) * rs, bflo(hw.y) * rs, bfhi(hw.y) * rs); w8.y = pk4_fp8(bflo(hw.z) * rs, bfhi(hw.z) * rs, bflo(hw.w) * rs, bfhi(hw.w) * rs);
                *(u32x2*)(((unsigned char*)(wsl + WS_HB8)) + (size_t)m * D + 32 * ks + 8 * fq) = w8; }
#pragma unroll
            for (int j = 0; j < 4; ++j) { LG[fr * 33 + 4 * fq + j] = acc0[j] * rs + ((const float*)(const GAS float*)(ka[29]))[4 * fq + j]; LG[fr * 33 + 16 + 4 * fq + j] = acc1[j] * rs + ((const float*)(const GAS float*)(ka[29]))[16 + 4 * fq + j]; }
            LDS_WAIT();
            int ek[4] = {0, 0, 0, 0}, pl[4] = {0, 0, 0, 0}; float wk[4] = {0.f, 0.f, 0.f, 0.f};
            if (lane < 16) {
                float v[32];
#pragma unroll
                for (int e = 0; e < 32; ++e) v[e] = LG[lane * 33 + e];
                float tv[4]; unsigned taken = 0u;
#pragma unroll
                for (int k = 0; k < 4; ++k) { float best = 0.f; int bi = -1;
#pragma unroll
                    for (int e = 0; e < 32; ++e) { const bool fre = ((taken >> e) & 1u) == 0u; if (fre && (bi < 0 || v[e] > best)) { best = v[e]; bi = e; } }
                    taken |= 1u << bi; tv[k] = best; ek[k] = bi; }
                float den = 0.f;
#pragma unroll
                for (int k = 0; k < 4; ++k) { wk[k] = __expf(tv[k] - tv[0]); den += wk[k]; }
                const float inv = 1.f / den;
#pragma unroll
                for (int k = 0; k < 4; ++k) { wk[k] *= inv; pl[k] = __hip_atomic_fetch_add(HIST + ek[k], 1, __ATOMIC_RELAXED, __HIP_MEMORY_SCOPE_WORKGROUP); }
            }
            __syncthreads();
            if (tid < NE) { const int hc = HIST[tid]; BASE[tid] = hc ? atomicAdd(((int*)((GAS unsigned*)(wsl + WS_CTL) + CW_CNT)) + tid * CNT_STRIDE, hc) : 0; }
            __syncthreads();
            if (lane < 16) {
#pragma unroll
                for (int k = 0; k < 4; ++k) { const int pos = BASE[ek[k]] + pl[k];
                    ((int*)(GAS int*)(wsl + WS_LTOK))[(size_t)ek[k] * ECAP + pos] = m; ((float*)(GAS float*)(wsl + WS_LRS))[(size_t)ek[k] * ECAP + pos] = rs; ((int*)(GAS int*)(wsl + WS_EP))[m * 4 + k] = (ek[k] << 16) | pos; ((float*)(GAS float*)(wsl + WS_WK))[m * 4 + k] = wk[k]; }
            }
            __syncthreads();
        }
    }
    SEAM(9);

    if (IN(11)) { PHASE_IDS(); int tend, cnt, NT; moe_prefix(((int*)((GAS unsigned*)(wsl + WS_CTL) + CW_CNT)), lane, tend, cnt, NT);
        LAS int* mtab = (LAS int*)(lds + 131072); mtab[lane] = tend; mtab[64 + lane] = cnt; LDS_WAIT(); __syncthreads();
        unsigned* xbar = (unsigned*)((GAS unsigned*)(wsl + WS_CTL)) + CW_BAR;
        unsigned cj = 0u, incl = 0u;
        for (unsigned sp = 0u;; ++sp) { cj = lane < 16 ? xb_ld(&xbar[XB_XCNT(lane)]) : 0u; incl = cj;
#pragma unroll
            for (int o = 1; o < 16; o <<= 1) { const unsigned v = __shfl_up(incl, o); if (lane >= o) incl += v; }
            if (__builtin_amdgcn_readlane(incl, 15) == (unsigned)G || sp > (1u << 20)) break; __builtin_amdgcn_s_sleep(1); }
        const int xcc = (int)xb_xcc_id(); const int nloc = (int)__builtin_amdgcn_readlane(cj, xcc), pend = (int)__builtin_amdgcn_readlane(incl, xcc), lrank = (int)MISC[12];
        const int rt0 = (int)(((long)NT * (pend - nloc)) / G), nrt = (int)(((long)NT * pend) / G) - rt0;
        GAS unsigned* done = (GAS unsigned*)(wsl + WS_CTL) + CW_DONE;
        const __amdgpu_buffer_rsrc_t rl = __builtin_amdgcn_make_buffer_rsrc((void*)((int*)(GAS int*)(wsl + WS_LTOK)), (short)0, NE * ECAP * 4, 0x00020000);
        { pg8::Gemm g{((unsigned char*)(wsl + WS_HB8)), ((bf16_t*)(GAS bf16_t*)(wsl + WS_WGU)), D}; MoeOrder<3> S{nloc, lrank, 8 * nrt, rt0, mtab, rl, done}; pg8::EpiSwiglu E{nullptr, (unsigned char*)((bf16_t*)(GAS bf16_t*)(wsl + WS_HMOE)), ((const float*)(const GAS float*)(ka[31])), ((float*)(GAS float*)(wsl + WS_LRS))};
          pg8::gemm_phase<pg8::EpiSwiglu, MoeOrder<3>, true, true, true>(lds, g, S, E, wave); }
        { const int i0 = 8 * nrt > lrank ? (8 * nrt - lrank + nloc - 1) / nloc : 0;
          pg8::Gemm g{((bf16_t*)(GAS bf16_t*)(wsl + WS_HMOE)), ((bf16_t*)(GAS bf16_t*)(wsl + WS_WDN)), D}; MoeOrder<2> S{nloc, i0 * nloc + lrank - 8 * nrt, 4 * nrt, rt0, mtab, rl, done}; pg8::EpiBf16<2> E{nullptr, ((bf16_t*)(GAS bf16_t*)(wsl + WS_YSLOT)), D, ((const float*)(const GAS float*)(ka[33])), W8_INV};
          pg8::gemm_phase<pg8::EpiBf16<2>, MoeOrder<2>, false, true, true>(lds, g, S, E, wave); }
    }
    SEAM(12);

    if (IN(13)) { PHASE_IDS(); int tend, cnt, NT; moe_prefix(((int*)((GAS unsigned*)(wsl + WS_CTL) + CW_CNT)), lane, tend, cnt, NT);
        int epn[2]; float wn[2];
#pragma unroll
        for (int r = 0; r < 2; ++r) { const int mm = gw + r * NGW; const int m = mm < M ? mm : 0; epn[r] = ((int*)(GAS int*)(wsl + WS_EP))[m * 4 + (lane & 3)]; wn[r] = ((float*)(GAS float*)(wsl + WS_WK))[m * 4 + (lane & 3)]; }
        for (int m0 = gw; m0 < M; m0 += 2 * NGW) {
            int slot[2]; float w[2]; int mr[2]; bool ok[2];
#pragma unroll
            for (int r = 0; r < 2; ++r) { mr[r] = m0 + r * NGW; ok[r] = mr[r] < M; const int m = ok[r] ? mr[r] : m0; mr[r] = m;
                const int ep = epn[r]; w[r] = wn[r]; const int e = ep >> 16, pos = ep & 0xffff;
                const int tprev = __shfl(tend, (e + 63) & 63); slot[r] = 256 * (e ? tprev : 0) + pos; }
#pragma unroll
            for (int r = 0; r < 2; ++r) { const int mm = m0 + 2 * NGW + r * NGW; const int m = mm < M ? mm : 0; epn[r] = ((int*)(GAS int*)(wsl + WS_EP))[m * 4 + (lane & 3)]; wn[r] = ((float*)(GAS float*)(wsl + WS_WK))[m * 4 + (lane & 3)]; }
            u32x2 hw[2][4];
#pragma unroll
            for (int r = 0; r < 2; ++r)
#pragma unroll
                for (int j = 0; j < 4; ++j) hw[r][j] = *((const u32x2*)(((bf16_t*)(GAS bf16_t*)(wsl + WS_HB)) + (size_t)mr[r] * D) + lane + 64 * j);
            unsigned yv[2][4][4]; float wk_[2][4];
#pragma unroll
            for (int r = 0; r < 2; ++r)
#pragma unroll
                for (int k = 0; k < 4; ++k) { int sk = __builtin_amdgcn_readlane(slot[r], k); sk = sk < 0 ? 0 : (sk >= SLOT_ROWS ? SLOT_ROWS - 1 : sk); wk_[r][k] = __int_as_float(__builtin_amdgcn_readlane(__float_as_int(w[r]), k));
                    const unsigned* yr = (const unsigned*)((const unsigned char*)((bf16_t*)(GAS bf16_t*)(wsl + WS_YSLOT)) + (size_t)sk * D) + lane;
#pragma unroll
                    for (int j = 0; j < 4; ++j) yv[r][k][j] = yr[64 * j]; }
#pragma unroll
            for (int r = 0; r < 2; ++r) { f32x4 v[4];
#pragma unroll
                for (int j = 0; j < 4; ++j) v[j] = (f32x4){bflo(hw[r][j].x), bfhi(hw[r][j].x), bflo(hw[r][j].y), bfhi(hw[r][j].y)};
#pragma unroll
                for (int k = 0; k < 4; ++k)
#pragma unroll
                    for (int j = 0; j < 4; ++j) { const unsigned y = yv[r][k][j]; const f32x2 lo = __builtin_amdgcn_cvt_pk_f32_fp8((int)y, false), hi = __builtin_amdgcn_cvt_pk_f32_fp8((int)y, true);
                        v[j].x += wk_[r][k] * lo[0]; v[j].y += wk_[r][k] * lo[1]; v[j].z += wk_[r][k] * hi[0]; v[j].w += wk_[r][k] * hi[1]; }
                float s = 0.f;
#pragma unroll
                for (int j = 0; j < 4; ++j) s += (v[j].x * v[j].x + v[j].y * v[j].y) + (v[j].z * v[j].z + v[j].w * v[j].w);
                const float rs = rsqrtf(wave_sum(s) * (1.f / D) + NORM_EPS);
                if (ok[r]) {
#pragma unroll
                    for (int j = 0; j < 4; ++j) { const f32x4 gg = *((const f32x4*)((const float*)(const GAS float*)(ka[34])) + lane + 64 * j); *((f32x4*)(OUT + (size_t)mr[r] * D) + lane + 64 * j) = v[j] * rs * gg; } } }
        }
    }
#undef IN
#undef SEAM
}

extern "C" void kernel_launch(void* const* d_in, const int* in_sizes, int n_in, void* d_out, int out_size, void* d_ws, size_t ws_size, hipStream_t stream) {
    static int grid = 0;
    if (grid == 0) {
        if (n_in != 35 || out_size != M * D || ws_size < WS_END) { fprintf(stderr, "kernel_launch: unexpected shapes (n_in %d, out %d, ws %zu); nothing launched\n", n_in, out_size, ws_size); grid = -1; return; }
        int dev = 0, cus = 0, per_cu = 0;
        if (hipGetDevice(&dev) != hipSuccess || hipDeviceGetAttribute(&cus, hipDeviceAttributeMultiprocessorCount, dev) != hipSuccess) { grid = -1; return; }
        if (hipFuncSetAttribute((const void*)hymba_fwd, hipFuncAttributeMaxDynamicSharedMemorySize, LDS_BYTES) != hipSuccess) { fprintf(stderr, "kernel_launch: hipFuncSetAttribute failed\n"); grid = -1; return; }
        if (hipOccupancyMaxActiveBlocksPerMultiprocessor(&per_cu, (const void*)hymba_fwd, NWAVES * 64, LDS_BYTES) != hipSuccess || per_cu < 1) {
            fprintf(stderr, "kernel_launch: occupancy query reports %d workgroups per CU\n", per_cu); (void)hipGetLastError(); grid = -1; return; }
        grid = cus;
    }
    if (grid < 0) return;
    (void)hipMemsetAsync((char*)d_ws + WS_CTL, 0, CTL_ZERO_BYTES, stream);
    Args a{};
    for (int i = 0; i < 35; ++i) a.in[i] = (const float*)d_in[i];
    a.out = (float*)d_out; a.ws = (unsigned char*)d_ws;
    if (MK_N_LAUNCHES == 1) { a.ph_lo = 0; a.ph_hi = N_PHASES; hipLaunchKernelGGL(hymba_fwd, dim3(grid), dim3(NWAVES * 64), LDS_BYTES, stream, a); }
    else { for (int p = 0; p < N_PHASES && p < MK_MAX_PHASE; ++p) { a.ph_lo = p; a.ph_hi = p + 1; hipLaunchKernelGGL(hymba_fwd, dim3(grid), dim3(NWAVES * 64), LDS_BYTES, stream, a); } }
}
```
